# Optimizing an MI355X kernel written in HIP

```python
import math
import jax, jax.numpy as jnp
from jax import lax
import numpy as np

D_MODEL = 2048
BATCH = 8
SEQ = 4096
DEPTH = 2

HEAD_DIM = 128
ATTN_SCALE = HEAD_DIM ** -0.5
ROPE_THETA = 10000.0
A_PATTERNS = ((128, 1), (512, 4), (2048, 16))
A_HEADS_PER_GROUP = 2
A_HEADS = A_HEADS_PER_GROUP * len(A_PATTERNS)
A_OUT = A_HEADS_PER_GROUP * HEAD_DIM
B_HEADS = 6
B_OUT = B_HEADS * HEAD_DIM
MOBA_BLOCK = 256
MOBA_TOPK = 3
MOBA_QUERY_CHUNK = 16
C_Q_HEADS = 8
C_KV_HEADS = 2
C_WINDOW = 128
C_OUT = C_Q_HEADS * HEAD_DIM
BAND_BLOCK = 128
N_Q_HEADS = A_HEADS + B_HEADS + C_Q_HEADS
N_KV_HEADS = A_HEADS + B_HEADS + C_KV_HEADS
N_BRANCHES = 3
N_GROUPS = 4
EXPERTS_PER_GROUP = 4
N_EXPERTS = N_GROUPS * EXPERTS_PER_GROUP
EXPERT_TOPK = 2
D_EXPERT = D_MODEL // 2
LN_EPS = 1e-5
DEEPNORM_ALPHA = (2 * DEPTH) ** 0.25
DEEPNORM_BETA = (8 * DEPTH) ** -0.25
NEG = -1e30

kernel_name = 'hybrid_dilated_moba_sinkswa_hmoe_deepnorm'


def _layer_norm(x, g, b):
    xf = x.astype(jnp.float32)
    mu = jnp.mean(xf, axis=-1, keepdims=True)
    var = jnp.mean(jnp.square(xf - mu), axis=-1, keepdims=True)
    return ((xf - mu) * lax.rsqrt(var + LN_EPS) * g + b).astype(x.dtype)


def _rope_tables(positions):
    inv = ROPE_THETA ** (-jnp.arange(0, HEAD_DIM, 2, dtype=jnp.float32) / HEAD_DIM)
    ang = positions.astype(jnp.float32)[..., None] * inv
    return jnp.cos(ang), jnp.sin(ang)


def _apply_rope(t, cos, sin):
    tf = t.astype(jnp.float32)
    t1, t2 = tf[..., :HEAD_DIM // 2], tf[..., HEAD_DIM // 2:]
    c, s = cos[:, :, None, :], sin[:, :, None, :]
    return jnp.concatenate([t1 * c - t2 * s, t2 * c + t1 * s], axis=-1).astype(t.dtype)


def _banded_attention(q, k, v, max_dist):
    B, L, Hk, G, hd = q.shape
    nb = L // BAND_BLOCK
    qb = q.reshape(B, nb, BAND_BLOCK, Hk, G, hd)

    def with_prev(t):
        t = t.reshape(B, nb, BAND_BLOCK, Hk, hd)
        prev = jnp.concatenate([jnp.zeros_like(t[:, :1]), t[:, :-1]], axis=1)
        return jnp.concatenate([prev, t], axis=2)

    kw, vw = with_prev(k), with_prev(v)
    s = jnp.einsum('bnqhgd,bnkhd->bnhgqk', qb, kw, preferred_element_type=jnp.float32) * ATTN_SCALE
    qi = jnp.arange(BAND_BLOCK)[:, None]
    kj = jnp.arange(2 * BAND_BLOCK)[None, :]
    dist = qi + BAND_BLOCK - kj
    blk = jnp.arange(nb)[:, None, None]
    valid = (dist >= 0) & (dist <= max_dist) & ((blk > 0) | (kj >= BAND_BLOCK))
    s = jnp.where(valid[None, :, None, None], s, NEG)
    lse = jax.nn.logsumexp(s, axis=-1)
    o = jnp.einsum('bnhgqk,bnkhd->bnqhgd', jnp.exp(s - lse[..., None]), vw)
    return o.reshape(B, L, Hk, G, hd), lse.transpose(0, 1, 4, 2, 3).reshape(B, L, Hk, G)


def _dilated_attention(q, k, v):
    B, S, _, hd = q.shape
    outs, lses = [], []
    for g, (window, dil) in enumerate(A_PATTERNS):
        hs = slice(g * A_HEADS_PER_GROUP, (g + 1) * A_HEADS_PER_GROUP)
        unit = dil * BAND_BLOCK
        s_pad = -(-S // unit) * unit
        L = s_pad // dil

        def by_residue(t):
            t = jnp.pad(t[:, :, hs], ((0, 0), (0, s_pad - S), (0, 0), (0, 0)))
            t = t.reshape(B, L, dil, A_HEADS_PER_GROUP, hd).transpose(0, 2, 1, 3, 4)
            return t.reshape(B * dil, L, A_HEADS_PER_GROUP, hd)

        o, lse = _banded_attention(by_residue(q)[:, :, :, None], by_residue(k), by_residue(v), window // dil)
        o = o[:, :, :, 0].reshape(B, dil, L, A_HEADS_PER_GROUP, hd).transpose(0, 2, 1, 3, 4)
        lse = lse[..., 0].reshape(B, dil, L, A_HEADS_PER_GROUP).transpose(0, 2, 1, 3)
        outs.append(o.reshape(B, s_pad, A_HEADS_PER_GROUP, hd)[:, :S])
        lses.append(lse.reshape(B, s_pad, A_HEADS_PER_GROUP)[:, :S])
    w = jax.nn.softmax(jnp.stack(lses), axis=0)
    o = jnp.einsum('gbsh,gbshd->bshd', w, jnp.stack(outs))
    return o.reshape(B, S, A_OUT)


def _moba_attention(q, k, v):
    B, S, H, hd = q.shape
    s_pad = -(-S // MOBA_BLOCK) * MOBA_BLOCK
    pad = ((0, 0), (0, s_pad - S), (0, 0), (0, 0))
    q, k, v = jnp.pad(q, pad), jnp.pad(k, pad), jnp.pad(v, pad)
    nblk = s_pad // MOBA_BLOCK
    qb = q.reshape(B, nblk, MOBA_BLOCK, H, hd)
    kb = k.reshape(B, nblk, MOBA_BLOCK, H, hd)
    vb = v.reshape(B, nblk, MOBA_BLOCK, H, hd)
    s = jnp.einsum('bnqhd,bnkhd->bnhqk', qb, kb, preferred_element_type=jnp.float32) * ATTN_SCALE
    causal = jnp.tril(jnp.ones((MOBA_BLOCK, MOBA_BLOCK), dtype=bool))
    s = jnp.where(causal, s, NEG)
    lse_own = jax.nn.logsumexp(s, axis=-1)
    o_own = jnp.einsum('bnhqk,bnkhd->bnqhd', jnp.exp(s - lse_own[..., None]), vb).reshape(B, s_pad, H, hd)
    lse_own = lse_own.transpose(0, 1, 3, 2).reshape(B, s_pad, H)
    k_mean = jnp.mean(kb.astype(jnp.float32), axis=2)
    gate = jnp.einsum('bshd,bnhd->bshn', q, k_mean, preferred_element_type=jnp.float32)
    n_past = jnp.arange(s_pad) // MOBA_BLOCK
    is_past = jnp.arange(nblk)[None, :] < n_past[:, None]
    gate = jnp.where(is_past[None, :, None, :], gate, NEG)
    n_sel = min(MOBA_TOPK, nblk)
    _, sel = lax.top_k(gate, n_sel)
    sel_ok = jnp.arange(n_sel)[None, :] < n_past[:, None]
    kbt = kb.transpose(0, 3, 1, 2, 4)
    vbt = vb.transpose(0, 3, 1, 2, 4)
    n_chunks = s_pad // MOBA_QUERY_CHUNK
    b_idx = jnp.arange(B)[:, None, None, None]
    h_idx = jnp.arange(H)[None, None, :, None]

    def to_chunks(t):
        return t.reshape((B, n_chunks, MOBA_QUERY_CHUNK) + t.shape[2:]).swapaxes(0, 1)

    def attend_selected(args):
        qc, selc, okc = args
        kg = kbt[b_idx, h_idx, selc]
        vg = vbt[b_idx, h_idx, selc]
        sc = jnp.einsum('bqhd,bqhrkd->bqhrk', qc, kg, preferred_element_type=jnp.float32) * ATTN_SCALE
        sc = jnp.where(okc[None, :, None, :, None], sc, NEG)
        lse = jax.nn.logsumexp(sc, axis=(-2, -1))
        o = jnp.einsum('bqhrk,bqhrkd->bqhd', jnp.exp(sc - lse[..., None, None]), vg)
        return o, lse

    o_sel, lse_sel = lax.map(attend_selected, (to_chunks(q), to_chunks(sel), sel_ok.reshape(n_chunks, MOBA_QUERY_CHUNK, n_sel)))
    o_sel = o_sel.swapaxes(0, 1).reshape(B, s_pad, H, hd)
    lse_sel = lse_sel.swapaxes(0, 1).reshape(B, s_pad, H)
    m = jnp.maximum(lse_own, lse_sel)
    w_own = jnp.exp(lse_own - m)[..., None]
    w_sel = jnp.exp(lse_sel - m)[..., None]
    o = (w_own * o_own + w_sel * o_sel) / (w_own + w_sel)
    return o[:, :S].reshape(B, S, B_OUT)


def _sink_window_attention(q, k, v, sinks):
    B, S, _, hd = q.shape
    grp = C_Q_HEADS // C_KV_HEADS
    o, lse = _banded_attention(q.reshape(B, S, C_KV_HEADS, grp, hd), k, v, C_WINDOW - 1)
    keep = jax.nn.sigmoid(lse - sinks.reshape(C_KV_HEADS, grp))
    return (o * keep[..., None]).reshape(B, S, C_OUT)


def _mixer(h, cos, sin, w_in, w_gate, b_gate, w_branch_a, w_branch_b, w_branch_c, w_out, sinks):
    B, S, D = h.shape
    proj = h @ w_in
    nq, nkv = N_Q_HEADS * HEAD_DIM, N_KV_HEADS * HEAD_DIM
    q = _apply_rope(proj[..., :nq].reshape(B, S, N_Q_HEADS, HEAD_DIM), cos, sin)
    k = _apply_rope(proj[..., nq:nq + nkv].reshape(B, S, N_KV_HEADS, HEAD_DIM), cos, sin)
    v = proj[..., nq + nkv:].reshape(B, S, N_KV_HEADS, HEAD_DIM)
    a0, b0 = A_HEADS, A_HEADS + B_HEADS
    out_a = _dilated_attention(q[:, :, :a0], k[:, :, :a0], v[:, :, :a0]).astype(h.dtype)
    out_b = _moba_attention(q[:, :, a0:b0], k[:, :, a0:b0], v[:, :, a0:b0]).astype(h.dtype)
    out_c = _sink_window_attention(q[:, :, b0:], k[:, :, b0:], v[:, :, b0:], sinks).astype(h.dtype)
    gates = jax.nn.sigmoid((h @ w_gate + b_gate).astype(jnp.float32)).reshape(B, S, N_BRANCHES, D)
    merged = (gates[:, :, 0] * (out_a @ w_branch_a) + gates[:, :, 1] * (out_b @ w_branch_b)
              + gates[:, :, 2] * (out_c @ w_branch_c)).astype(h.dtype)
    return merged @ w_out


def _hier_moe(h, w_router_group, w_router_expert, w_exp_gate, w_exp_up, w_exp_down):
    B, S, D = h.shape
    t = h.reshape(B * S, D)
    g_prob = jax.nn.softmax((t @ w_router_group).astype(jnp.float32), axis=-1)
    g_val, g_sel = lax.top_k(g_prob, 1)
    e_logit = (t @ w_router_expert).astype(jnp.float32).reshape(-1, N_GROUPS, EXPERTS_PER_GROUP)
    e_logit = jnp.take_along_axis(e_logit, g_sel[:, :, None], axis=1)[:, 0]
    e_val, e_sel = lax.top_k(e_logit, EXPERT_TOPK)
    w = jax.nn.softmax(e_val, axis=-1) * g_val
    expert_id = g_sel * EXPERTS_PER_GROUP + e_sel
    comb = jnp.einsum('tk,tke->te', w, jax.nn.one_hot(expert_id, N_EXPERTS, dtype=jnp.float32))
    out = jnp.zeros((B * S, D), jnp.float32)
    for e in range(N_EXPERTS):
        hid = jax.nn.silu(t @ w_exp_gate[e]) * (t @ w_exp_up[e])
        out = out + comb[:, e:e + 1] * (hid @ w_exp_down[e])
    return out.reshape(B, S, D).astype(h.dtype)


def setup_inputs(seed: int = 0) -> dict:
    key = jax.random.key(seed)
    ks = jax.random.split(key, 20)
    f32 = jnp.float32
    d = D_MODEL

    def nrm(k, shape, scale):
        return jax.random.normal(k, shape, f32) * scale

    qk_cols = (N_Q_HEADS + N_KV_HEADS) * HEAD_DIM
    v_cols = N_KV_HEADS * HEAD_DIM
    x = nrm(ks[0], (BATCH, SEQ, d), 1.0)
    offsets = jax.random.randint(ks[1], (BATCH, 1), 0, 1024, dtype=jnp.int32)
    positions = offsets + jnp.arange(SEQ, dtype=jnp.int32)[None, :]
    w_in = jnp.concatenate([nrm(ks[2], (DEPTH, d, qk_cols), d ** -0.5),
                            nrm(ks[3], (DEPTH, d, v_cols), DEEPNORM_BETA * d ** -0.5)], axis=-1)
    w_gate = nrm(ks[4], (DEPTH, d, N_BRANCHES * d), d ** -0.5)
    b_gate = nrm(ks[5], (DEPTH, N_BRANCHES * d), 0.02)
    w_branch_a = nrm(ks[6], (DEPTH, A_OUT, d), A_OUT ** -0.5)
    w_branch_b = nrm(ks[7], (DEPTH, B_OUT, d), B_OUT ** -0.5)
    w_branch_c = nrm(ks[8], (DEPTH, C_OUT, d), C_OUT ** -0.5)
    w_out = nrm(ks[9], (DEPTH, d, d), DEEPNORM_BETA * d ** -0.5)
    sinks = 4.0 + nrm(ks[10], (DEPTH, C_Q_HEADS), 1.0)
    ln1_g = 1.0 + nrm(ks[11], (DEPTH, d), 0.02)
    ln1_b = nrm(ks[12], (DEPTH, d), 0.02)
    w_router_group = nrm(ks[13], (DEPTH, d, N_GROUPS), d ** -0.5)
    w_router_expert = nrm(ks[14], (DEPTH, d, N_EXPERTS), d ** -0.5)
    w_exp_gate = nrm(ks[15], (DEPTH, N_EXPERTS, d, D_EXPERT), DEEPNORM_BETA * d ** -0.5)
    w_exp_up = nrm(ks[16], (DEPTH, N_EXPERTS, d, D_EXPERT), DEEPNORM_BETA * d ** -0.5)
    w_exp_down = nrm(ks[17], (DEPTH, N_EXPERTS, D_EXPERT, d), DEEPNORM_BETA * D_EXPERT ** -0.5)
    ln2_g = 1.0 + nrm(ks[18], (DEPTH, d), 0.02)
    ln2_b = nrm(ks[19], (DEPTH, d), 0.02)
    return {'x': x, 'positions': positions, 'w_in': w_in, 'w_gate': w_gate, 'b_gate': b_gate,
            'w_branch_a': w_branch_a, 'w_branch_b': w_branch_b, 'w_branch_c': w_branch_c,
            'w_out': w_out, 'sinks': sinks, 'ln1_g': ln1_g, 'ln1_b': ln1_b,
            'w_router_group': w_router_group, 'w_router_expert': w_router_expert,
            'w_exp_gate': w_exp_gate, 'w_exp_up': w_exp_up, 'w_exp_down': w_exp_down,
            'ln2_g': ln2_g, 'ln2_b': ln2_b}


def reference(x, positions, w_in, w_gate, b_gate, w_branch_a, w_branch_b, w_branch_c, w_out, sinks,
              ln1_g, ln1_b, w_router_group, w_router_expert, w_exp_gate, w_exp_up, w_exp_down,
              ln2_g, ln2_b):
    cos, sin = _rope_tables(positions)
    h = x
    for l in range(DEPTH):
        mix = _mixer(h, cos, sin, w_in[l], w_gate[l], b_gate[l], w_branch_a[l], w_branch_b[l],
                     w_branch_c[l], w_out[l], sinks[l])
        h = _layer_norm(DEEPNORM_ALPHA * h + mix, ln1_g[l], ln1_b[l])
        ffn = _hier_moe(h, w_router_group[l], w_router_expert[l], w_exp_gate[l], w_exp_up[l], w_exp_down[l])
        h = _layer_norm(DEEPNORM_ALPHA * h + ffn, ln2_g[l], ln2_b[l])
    return h
```

```cpp
#include <hip/hip_runtime.h>
#include <cstdio>
#include <cstdint>

#ifndef DBL_MASK
#define DBL_MASK 0
#endif
#define REP(k) for (int rep_ = 0; rep_ < (((DBL_MASK >> (k)) & 1) ? 2 : 1); ++rep_)
#ifndef ATT_NAIVE_MASK
#define ATT_NAIVE_MASK 0
#endif
#ifndef MK_ONE_LAUNCH
#define MK_ONE_LAUNCH 1
#endif

#define LAS __attribute__((address_space(3)))
#define GAS __attribute__((address_space(1)))
typedef unsigned short bf16;
typedef short bf16x8 __attribute__((ext_vector_type(8)));
typedef float f32x4 __attribute__((ext_vector_type(4)));
typedef float f32x2 __attribute__((ext_vector_type(2)));
typedef unsigned u32x4 __attribute__((ext_vector_type(4)));
typedef unsigned u32x2 __attribute__((ext_vector_type(2)));

constexpr int D = 2048, NBATCH = 8, SEQ = 4096, T = NBATCH * SEQ, DEPTH = 2, HD = 128;
constexpr int NQH = 20, NKVH = 14, NPROJ = (NQH + 2 * NKVH) * HD;
constexpr int KOFF = NQH * HD, VOFF = (NQH + NKVH) * HD;
constexpr int NEXP = 16, DEXP = 1024;
constexpr int MAXSLOT = 2 * T + NEXP * 256;
constexpr float LN_EPS = 1e-5f;
constexpr float DN_ALPHA = 1.4142135623730951f;
constexpr float QSCALE = 0.08838834764831845f * 1.4426950408889634f;
constexpr float LN2F = 0.6931471805599453f;
constexpr int NPH = 13;

constexpr size_t MiB = 1u << 20;
constexpr size_t WS_CTL = 0, CTL_ZERO_BYTES = 1 * MiB;
constexpr size_t WS_ROUTE_E = 1 * MiB;
constexpr size_t WS_ROUTE_W = WS_ROUTE_E + (size_t)T * 8;
constexpr size_t WS_ROWTOK = WS_ROUTE_W + (size_t)T * 8;
constexpr size_t WS_ROWDST = WS_ROWTOK + (size_t)MAXSLOT * 4;
constexpr size_t WS_ROWW = WS_ROWDST + (size_t)MAXSLOT * 4;
constexpr size_t WS_CNTWG = WS_ROWW + (size_t)MAXSLOT * 4;
constexpr size_t WS_TILEOFF = WS_CNTWG + 256 * 16 * 4;
constexpr size_t WS_KMEAN = WS_TILEOFF + 256;
constexpr size_t WS_MISC_END = WS_KMEAN + (size_t)NBATCH * 16 * 6 * 128 * 4 * 4;
static_assert(WS_MISC_END <= 8 * MiB, "misc region");
constexpr size_t WS_ROPE = 8 * MiB;
constexpr size_t WS_SCR = 24 * MiB;
constexpr size_t WS_W = 88 * MiB;
constexpr size_t WS_HB = 344 * MiB;
constexpr size_t WS_R1 = 472 * MiB;
constexpr size_t WS_R2 = 856 * MiB;
constexpr size_t WS_R3 = 984 * MiB;
constexpr size_t WS_HB8 = 1112 * MiB;
constexpr size_t WS_END = 1176 * MiB;
constexpr size_t WO_IN = 0, WO_GATE = WO_IN + (size_t)NPROJ * D, WO_BR = WO_GATE + (size_t)NPROJ * D, WO_OUT = WO_BR + (size_t)D * D,
                 WO_GU = WO_OUT + (size_t)D * D, WO_DN = WO_GU + (size_t)NEXP * 2048 * D, WO_END = WO_DN + (size_t)NEXP * D * DEXP;
static_assert(WO_END * 2 == 256 * MiB, "weights region");
constexpr size_t W8_IN = WO_IN * 2, W8_GATE = WO_GATE * 2, W8_GU = WO_GU * 2, W8_DN = WO_DN * 2;
constexpr float W8_SCALE = 64.f, W8_INV = 1.f / 64.f, HID8_INV = 1.f / 8.f;
constexpr int CW_BAR = 4096;

constexpr int RING_BYTES = 131072;
constexpr int LDS_BYTES = 163840;
constexpr int LDSCTL_OFF = LDS_BYTES - 1024, MISC_OFF = LDSCTL_OFF + 320;

#define LDS_WAIT() asm volatile("s_waitcnt lgkmcnt(0)" ::: "memory")
#define VM_WAIT() asm volatile("s_waitcnt vmcnt(0)" ::: "memory")
__device__ __forceinline__ unsigned f2bf(float f) { unsigned u = __builtin_bit_cast(unsigned, f); return (u + 0x7fffu + ((u >> 16) & 1u)) >> 16; }
__device__ __forceinline__ unsigned pk2(float lo, float hi) { return f2bf(lo) | (f2bf(hi) << 16); }
__device__ __forceinline__ float bflo(unsigned w) { return __builtin_bit_cast(float, w << 16); }
__device__ __forceinline__ float bfhi(unsigned w) { return __builtin_bit_cast(float, w & 0xffff0000u); }
typedef __bf16 bf16x2_t __attribute__((ext_vector_type(2)));
__device__ __forceinline__ unsigned cvt_pk_bf16(float lo, float hi) { f32x2 v = {lo, hi}; bf16x2_t b = __builtin_convertvector(v, bf16x2_t); return __builtin_bit_cast(unsigned, b); }

namespace pg8 {
constexpr int BM = 256, BK = 64, HALF = 128, HTB = HALF * BK * 2, STAGE_BYTES = 8 * HTB, NXCD = 8, WGM = 8;
__host__ __device__ __forceinline__ int lds_byte(int r, int c) { const int st = (r >> 4) * 2 + (c >> 5), rr = r & 15, cc = c & 31, ob = rr * 64 + cc * 2; return st * 1024 + (ob ^ (((ob >> 9) & 1) << 5)); }
__host__ __device__ __forceinline__ void stage_rc(int b, int& R, int& C) { const int st = b / 1024, sb = b % 1024, swz = sb ^ (((sb >> 9) & 1) << 5); R = (st >> 1) * 16 + swz / 64; C = (st & 1) * 32 + (swz % 64) / 2; }
__host__ __device__ __forceinline__ int perm32(int rho) { const int n = rho >> 4, i = rho & 15; return 8 * (i >> 2) + 4 * n + (i & 3); }

struct Unit { int pm, pn, z; };
#define GPC0(T_, base, off) ((const T_*)((const char*)(base) + (unsigned)(off)))
__device__ __forceinline__ void xcd_order(int L, int nM, int nN, int& pm, int& pn) {
    const int nwg = nM * nN; int wgid = L; { const int q = nwg / NXCD, r = nwg % NXCD, xcd = wgid % NXCD, off = wgid / NXCD; wgid = (xcd < r ? xcd * (q + 1) : r * (q + 1) + (xcd - r) * q) + off; }
    const int nig = WGM * nN, gid = wgid / nig, fm = gid * WGM, gsz = (nM - fm) < WGM ? (nM - fm) : WGM;
    pm = fm + ((wgid % nig) % gsz); pn = (wgid % nig) / gsz;
}

__host__ __device__ __forceinline__ int f8swz(int r) { return ((r >> 1) & 1) + 6 * (r >> 3); }
template <bool F8> __device__ __forceinline__ void stage_map(int b, int& R, int& CB) {
    if constexpr (F8) { R = b >> 7; CB = 16 * (((b >> 4) & 7) ^ f8swz(R & 15)); }
    else { int C; stage_rc(b, R, C); CB = C * 2; }
}
typedef int v4i __attribute__((ext_vector_type(4)));
typedef int v8i __attribute__((ext_vector_type(8)));
template <class Epi, class Sched, bool ALIGN_EPI, bool GATHER, bool F8 = false>
__device__ __forceinline__ void gemm_phase(LAS unsigned char* lds, const Sched& S, const Epi& E, const int tid) {
    const int wid = __builtin_amdgcn_readfirstlane(tid >> 6), lane = tid & 63, wr = wid >> 2, wc = wid & 3, fr = lane & 15, fq = lane >> 4;
    const unsigned lda = S.lda, ldb = S.ldb;
    unsigned voffB, voA[2][2], vnA[2][2];
    { int R, CB; stage_map<F8>(tid * 16, R, CB); const int Rb = Epi::PERM ? ((R & ~31) + perm32(R & 31)) : R;
      voffB = (unsigned)Rb * ldb + (unsigned)CB;
      voA[0][0] = (unsigned)R * lda + (unsigned)CB; voA[0][1] = voA[0][0]; voA[1][0] = voA[0][0]; voA[1][1] = voA[0][0];
      vnA[0][0] = voA[0][0]; vnA[0][1] = voA[0][0]; vnA[1][0] = voA[0][0]; vnA[1][1] = voA[0][0]; }
    const unsigned qstepA = 64u * lda, qstepB = 64u * ldb;
    const auto rsA = __builtin_amdgcn_make_buffer_rsrc((void*)S.A, 0, 0xffffffff, 0x00020000);
    const auto rsB = __builtin_amdgcn_make_buffer_rsrc((void*)S.Bt, 0, 0xffffffff, 0x00020000);
    const unsigned kstep = (unsigned)(BK * 2);
    const unsigned hstepB = (unsigned)HALF * ldb, hstepA = (unsigned)HALF * lda;
    const unsigned ldsw = (unsigned)wid * 1024u;
    const int aoff = F8 ? ((wr * 64 + fr) * 128 + 16 * ((2 * fq) ^ f8swz(fr))) : lds_byte(wr * 64 + fr, fq * 8);
    const int boff = F8 ? ((wc * 32 + fr) * 128 + 16 * ((2 * fq) ^ f8swz(fr))) : lds_byte(wc * 32 + fr, fq * 8);
#define PG8_OFF1(o) (F8 ? ({ int _o = (o); asm volatile("" : "+v"(_o)); _o ^ 16; }) : ((o) + 1024))
#define PG8_SA(b, h) (((b) * 2 + (h)) * HTB)
#define PG8_SB(b, h) ((4 + (b) * 2 + (h)) * HTB)
#define PG8_DMA(bufoff, i_, rs, vo, so) __builtin_amdgcn_raw_ptr_buffer_load_lds(rs, (LAS void*)(lds + (bufoff) + ldsw + (i_) * 8192), 16, (int)(vo), (int)(so), 0, 0)
#define PG8_STAGE_B(b, h, kb) do { PG8_DMA(PG8_SB(b, h), 0, rsB, voffB, (kb) + (h) * hstepB); PG8_DMA(PG8_SB(b, h), 1, rsB, voffB, (kb) + (h) * hstepB + qstepB); } while (0)
#define PG8_STAGE_A(b, h, ka, VO) do { if constexpr (GATHER) { PG8_DMA(PG8_SA(b, h), 0, rsA, (VO)[h][0], (ka)); PG8_DMA(PG8_SA(b, h), 1, rsA, (VO)[h][1], (ka)); } \
        else { PG8_DMA(PG8_SA(b, h), 0, rsA, (VO)[0][0], (ka) + (h) * hstepA); PG8_DMA(PG8_SA(b, h), 1, rsA, (VO)[0][0], (ka) + (h) * hstepA + qstepA); } } while (0)
#define PG8_LDA(dst, b, h) do { const int _a1 = PG8_OFF1(aoff); _Pragma("unroll") for (int m = 0; m < 4; ++m) { dst[m][0] = *(const LAS bf16x8*)(lds + PG8_SA(b, h) + aoff + m * 2048); dst[m][1] = *(const LAS bf16x8*)(lds + PG8_SA(b, h) + _a1 + m * 2048); } } while (0)
#define PG8_LDB(dst, b, h) do { const int _b1 = PG8_OFF1(boff); _Pragma("unroll") for (int n = 0; n < 2; ++n) { dst[n][0] = *(const LAS bf16x8*)(lds + PG8_SB(b, h) + boff + n * 2048); dst[n][1] = *(const LAS bf16x8*)(lds + PG8_SB(b, h) + _b1 + n * 2048); } } while (0)
#define PG8_CAT(x) __builtin_shufflevector(__builtin_bit_cast(v4i, (x)[0]), __builtin_bit_cast(v4i, (x)[1]), 0, 1, 2, 3, 4, 5, 6, 7)
#define PG8_MMA(ai, bj, At, Bt) do { int f8scale = 0x7f7f7f7f; if constexpr (F8) asm volatile("" : "+v"(f8scale)); __builtin_amdgcn_s_setprio(1); _Pragma("unroll") for (int m = 0; m < 4; ++m) _Pragma("unroll") for (int n = 0; n < 2; ++n) { \
        if constexpr (F8) acc[ai][bj][m][n] = __builtin_amdgcn_mfma_scale_f32_16x16x128_f8f6f4(PG8_CAT(Bt[n]), PG8_CAT(At[m]), acc[ai][bj][m][n], 0, 0, 0, f8scale, 0, f8scale); \
        else { _Pragma("unroll") for (int k = 0; k < 2; ++k) acc[ai][bj][m][n] = __builtin_amdgcn_mfma_f32_16x16x32_bf16(Bt[n][k], At[m][k], acc[ai][bj][m][n], 0, 0, 0); } } \
        __builtin_amdgcn_s_setprio(0); } while (0)
#define PG8_WAIT_V(n) asm volatile("s_waitcnt vmcnt(" #n ")" ::: "memory")
#define PG8_WAIT_L(n) asm volatile("s_waitcnt lgkmcnt(" #n ")" ::: "memory")
#define PG8_BAR __builtin_amdgcn_s_barrier()
#define PG8_SCHED __builtin_amdgcn_sched_barrier(0)
    Unit cur, nxt; int ui = 0;
    if (!S.next(0, cur)) return;
    f32x4 acc[2][2][4][2];
#pragma unroll
    for (int a = 0; a < 2; ++a)
#pragma unroll
        for (int b = 0; b < 2; ++b)
#pragma unroll
            for (int m = 0; m < 4; ++m)
#pragma unroll
                for (int n = 0; n < 2; ++n) acc[a][b][m][n] = (f32x4){0.f, 0.f, 0.f, 0.f};
    bf16x8 At[4][2], B0[2][2], B1[2][2];
    if constexpr (GATHER) { S.rows(cur, wid * 64, voA); }
    unsigned cA = S.a_off(cur), cB = S.b_off(cur); int nt = S.nkt(cur);
    PG8_STAGE_B(0, 0, cB); PG8_STAGE_B(0, 1, cB); PG8_STAGE_A(0, 0, cA, voA); PG8_STAGE_A(0, 1, cA, voA);
    if (wr == 1) PG8_BAR;
    PG8_WAIT_V(2); PG8_BAR;
    PG8_STAGE_B(1, 0, cB + kstep); PG8_STAGE_A(1, 0, cA + kstep, voA); PG8_STAGE_B(1, 1, cB + kstep);
    PG8_WAIT_V(6); PG8_BAR;
    for (;;) {
        const bool has_next = S.next(ui + 1, nxt);
        const unsigned nA = has_next ? S.a_off(nxt) : cA, nB = has_next ? S.b_off(nxt) : cB;
        if constexpr (GATHER) { if (has_next) S.rows(nxt, wid * 64, vnA); else { vnA[0][0] = voA[0][0]; vnA[0][1] = voA[0][1]; vnA[1][0] = voA[1][0]; vnA[1][1] = voA[1][1]; } }
        for (int t = 0; t < nt; t += 2) {
            if constexpr (Epi::HOOK) { if (t == 4 || t == 16) { unsigned z_ = 0u; asm volatile("" : "+v"(z_)); const int l2 = (int)__builtin_amdgcn_mbcnt_hi(~0u, __builtin_amdgcn_mbcnt_lo(~0u, z_)); E.hook(acc, cur, t, wr, wc, l2 & 15, l2 >> 4); } }
            const bool last = (t == nt - 2);
            const unsigned a1 = cA + (unsigned)(t + 1) * kstep;
            const unsigned a2 = last ? nA : cA + (unsigned)(t + 2) * kstep, b2 = last ? nB : cB + (unsigned)(t + 2) * kstep;
            const unsigned a3 = a2 + kstep, b3 = b2 + kstep;
            __builtin_amdgcn_s_setprio(2); PG8_LDB(B0, 0, 0); PG8_LDB(B1, 0, 1); PG8_SCHED; PG8_LDA(At, 0, 0); PG8_STAGE_A(1, 1, a1, voA);
            if constexpr (GATHER) { if (last) { voA[0][0] = vnA[0][0]; voA[0][1] = vnA[0][1]; voA[1][0] = vnA[1][0]; voA[1][1] = vnA[1][1]; } }
            __builtin_amdgcn_s_setprio(0); PG8_WAIT_V(8); PG8_WAIT_L(0); PG8_BAR; PG8_MMA(0, 0, At, B0); PG8_MMA(0, 1, At, B1); PG8_BAR; PG8_SCHED;
            __builtin_amdgcn_s_setprio(2); PG8_LDA(At, 0, 1); PG8_STAGE_B(0, 0, b2); PG8_STAGE_B(0, 1, b2); PG8_STAGE_A(0, 0, a2, voA);
            __builtin_amdgcn_s_setprio(0); PG8_WAIT_V(8); PG8_WAIT_L(0); PG8_BAR; PG8_MMA(1, 0, At, B0); PG8_MMA(1, 1, At, B1); PG8_BAR; PG8_SCHED;
            __builtin_amdgcn_s_setprio(2); PG8_LDB(B0, 1, 0); PG8_LDB(B1, 1, 1); PG8_SCHED; PG8_LDA(At, 1, 0); PG8_STAGE_A(0, 1, a2, voA);
            __builtin_amdgcn_s_setprio(0); PG8_WAIT_V(8); PG8_WAIT_L(0); PG8_BAR; PG8_MMA(0, 0, At, B0); PG8_MMA(0, 1, At, B1); PG8_BAR; PG8_SCHED;
            __builtin_amdgcn_s_setprio(2); PG8_LDA(At, 1, 1); PG8_STAGE_B(1, 0, b3); PG8_STAGE_B(1, 1, b3); PG8_STAGE_A(1, 0, a3, voA);
            __builtin_amdgcn_s_setprio(0); PG8_WAIT_V(8); PG8_WAIT_L(0); PG8_BAR; PG8_MMA(1, 0, At, B0); PG8_MMA(1, 1, At, B1); PG8_BAR; PG8_SCHED;
        }
        if constexpr (ALIGN_EPI) { if (wr == 0) PG8_BAR; }
        { unsigned z_ = 0u; asm volatile("" : "+v"(z_)); const int l2 = (int)__builtin_amdgcn_mbcnt_hi(~0u, __builtin_amdgcn_mbcnt_lo(~0u, z_)); E(acc, cur, wr, wc, l2 & 15, l2 >> 4, wid * 64 + l2); }
        if (!has_next) break;
#pragma unroll
        for (int a = 0; a < 2; ++a)
#pragma unroll
            for (int b = 0; b < 2; ++b)
#pragma unroll
                for (int m = 0; m < 4; ++m)
#pragma unroll
                    for (int n = 0; n < 2; ++n) acc[a][b][m][n] = (f32x4){0.f, 0.f, 0.f, 0.f};
        cur = nxt; cA = nA; cB = nB; nt = S.nkt(cur); ++ui;
        if constexpr (ALIGN_EPI) { if (wr == 1) PG8_BAR; }
    }
    PG8_WAIT_V(0);
    if constexpr (!ALIGN_EPI) { if (wr == 0) PG8_BAR; }
    PG8_BAR;
#undef PG8_SA
#undef PG8_SB
#undef PG8_DMA
#undef PG8_STAGE_A
#undef PG8_STAGE_B
#undef PG8_LDA
#undef PG8_LDB
#undef PG8_MMA
#undef PG8_CAT
#undef PG8_OFF1
#undef PG8_WAIT_V
#undef PG8_WAIT_L
#undef PG8_BAR
#undef PG8_SCHED
}

struct SchedDense {
    const char* A; const char* Bt; unsigned lda, ldb; int nM, nN, G, c, nk;
    __device__ __forceinline__ bool next(int i, Unit& u) const { const int L = i * G + c; if (L >= nM * nN) return false; xcd_order(L, nM, nN, u.pm, u.pn); u.z = 0; return true; }
    __device__ __forceinline__ unsigned a_off(const Unit& u) const { return (unsigned)u.pm * 256u * lda; }
    __device__ __forceinline__ unsigned b_off(const Unit& u) const { return (unsigned)u.pn * 256u * ldb; }
    __device__ __forceinline__ int nkt(const Unit&) const { return nk; }
    __device__ __forceinline__ void rows(const Unit&, int, unsigned (&)[2][2]) const {}
};
struct SchedMerge {
    const char* A; const char* Bt; unsigned lda, ldb; int nM, nN, G, c;
    __device__ __forceinline__ bool next(int i, Unit& u) const { const int i3 = i / 3; const int L = i3 * G + c; if (L >= nM * nN) return false; xcd_order(L, nM, nN, u.pm, u.pn); u.z = i - 3 * i3; return true; }
    __device__ __forceinline__ int koff(int z) const { return z == 0 ? 0 : (z == 1 ? 256 : 1024); }
    __device__ __forceinline__ unsigned a_off(const Unit& u) const { return (unsigned)u.pm * 256u * lda + (unsigned)koff(u.z) * 2u; }
    __device__ __forceinline__ unsigned b_off(const Unit& u) const { return (unsigned)u.pn * 256u * ldb + (unsigned)koff(u.z) * 2u; }
    __device__ __forceinline__ int nkt(const Unit& u) const { return u.z == 0 ? 4 : (u.z == 1 ? 12 : 16); }
    __device__ __forceinline__ void rows(const Unit&, int, unsigned (&)[2][2]) const {}
};
struct SchedMoe {
    const char* A; const char* Bt; unsigned lda, ldb; size_t bexp  ; int nN, G, c, nk; const LAS int* tile_off; const int* row_tok; bool f8;
    __device__ __forceinline__ bool next(int i, Unit& u) const {
        const int ntile = __builtin_amdgcn_readfirstlane(tile_off[16]); int rt, pn;
        if (nN == 8 && (G & 31) == 0) {
            const int x = c & 7, v = c >> 3;
            rt = i * (G >> 3) + (x >> 1) * (G >> 5) + (v >> 2); pn = 4 * (x & 1) + (v & 3);
        } else { const int L = i * G + c; rt = L / nN; pn = L - rt * nN; }
        if (rt >= ntile) return false;
        u.pm = rt; u.pn = pn; int e = 0;
#pragma unroll
        for (int j = 1; j < 16; ++j) e += (rt >= tile_off[j]) ? 1 : 0;
        u.z = __builtin_amdgcn_readfirstlane(e); return true; }
    __device__ __forceinline__ unsigned a_off(const Unit& u) const { return row_tok ? 0u : (unsigned)u.pm * 256u * lda; }
    __device__ __forceinline__ unsigned b_off(const Unit& u) const { return (unsigned)u.z * (unsigned)bexp + (unsigned)u.pn * 256u * ldb; }
    __device__ __forceinline__ int nkt(const Unit&) const { return nk; }
    __device__ __forceinline__ void rows(const Unit& u, int tid, unsigned (&vo)[2][2]) const {
#pragma unroll
        for (int i = 0; i < 2; ++i) { unsigned z_ = 0u; asm volatile("" : "+v"(z_)); const int t2 = (tid & ~63) + (int)__builtin_amdgcn_mbcnt_hi(~0u, __builtin_amdgcn_mbcnt_lo(~0u, z_)); int R, CB; if (f8) stage_map<true>(t2 * 16 + i * 8192, R, CB); else stage_map<false>(t2 * 16 + i * 8192, R, CB);
#pragma unroll
            for (int h = 0; h < 2; ++h) vo[h][i] = (unsigned)(*GPC0(int, row_tok, (unsigned)(u.pm * 256 + h * HALF + R) * 4)) * lda + (unsigned)CB; }
    }
};

#define GP(T_, base, off) ((T_*)((char*)(base) + (unsigned)(off)))
#define GPC(T_, base, off) ((const T_*)((const char*)(base) + (unsigned)(off)))
struct EpiRope {
    static constexpr bool PERM = true;
    static constexpr bool HOOK = false;
    bf16* O; const float* rope; float ascale;
    __device__ __forceinline__ void operator()(const f32x4 (&acc)[2][2][4][2], const Unit& u, int wr, int wc, int fr, int fq, int tid) const {
        const int row0 = u.pm * BM + wr * 64 + fr, hh = wc >> 1, dd0 = 32 * (wc & 1) + 8 * fq, col0 = (2 * u.pn + hh) * HD + dd0;
        const bool is_rope = u.pn < 17; const float sc = ((u.pn < 10) ? QSCALE : 1.f) * ascale;
        const unsigned ooff = (unsigned)row0 * (NPROJ * 2) + (unsigned)col0 * 2, roff = (unsigned)row0 * 512 + (unsigned)dd0 * 4;
        f32x4 rr[2][2][4];
        auto ldr = [&](int b_, f32x4 (&dst)[2][4]) { const int ai = b_ >> 1, mh = b_ & 1;
#pragma unroll
            for (int mm = 0; mm < 2; ++mm) { const f32x4* rp = GPC(f32x4, rope, roff + (unsigned)(ai * HALF + (2 * mh + mm) * 16) * 512);
                dst[mm][0] = rp[0]; dst[mm][1] = rp[1]; dst[mm][2] = rp[16]; dst[mm][3] = rp[17]; } };
        ldr(0, rr[0]);
#pragma unroll
        for (int b_ = 0; b_ < 4; ++b_) { const int ai = b_ >> 1, mh = b_ & 1;
                if (b_ + 1 < 4) ldr(b_ + 1, rr[(b_ + 1) & 1]);
                asm volatile("" ::: "memory");
#pragma unroll
                for (int mm = 0; mm < 2; ++mm) { const int m = 2 * mh + mm; const unsigned rsel = (unsigned)(ai * HALF + m * 16);
                    u32x4 w1, w2;
#pragma unroll
                    for (int n = 0; n < 2; ++n) {
                        f32x4 x1 = acc[ai][0][m][n] * sc, x2 = acc[ai][1][m][n] * sc;
                        if (is_rope) { const f32x4 c = rr[b_ & 1][mm][n], sn = rr[b_ & 1][mm][2 + n];
                            const f32x4 y1 = x1 * c - x2 * sn, y2 = x2 * c + x1 * sn; x1 = y1; x2 = y2; }
                        const unsigned a0 = cvt_pk_bf16(x1[0], x1[1]), a1 = cvt_pk_bf16(x1[2], x1[3]), b0 = cvt_pk_bf16(x2[0], x2[1]), b1 = cvt_pk_bf16(x2[2], x2[3]);
                        if (n == 0) { w1.x = a0; w1.y = a1; w2.x = b0; w2.y = b1; } else { w1.z = a0; w1.w = a1; w2.z = b0; w2.w = b1; }
                    }
                    u32x4* rowp = GP(u32x4, O, ooff + rsel * (NPROJ * 2));
                    rowp[0] = w1; rowp[8] = w2; }
                asm volatile("" ::: "memory");
            }
    }
};
__device__ __forceinline__ float sigmoid_f(float x) { return __builtin_amdgcn_rcpf(1.f + __expf(-x)); }
__device__ __forceinline__ unsigned q8(float g) { return (unsigned)(g * 255.f + 0.5f); }
struct EpiGate {
    static constexpr bool PERM = true;
    static constexpr bool HOOK = false;
    unsigned char* O; const float* bias; float ascale;
    __device__ __forceinline__ void operator()(const f32x4 (&acc)[2][2][4][2], const Unit& u, int wr, int wc, int fr, int fq, int tid) const {
        const int row0 = u.pm * BM + wr * 64 + fr, col0 = u.pn * BM + wc * 32 + 8 * fq;
        const unsigned ooff = (unsigned)row0 * NPROJ + (unsigned)col0;
        f32x4 bb[2][2];
#pragma unroll
        for (int bj = 0; bj < 2; ++bj) { bb[bj][0] = *GPC(f32x4, bias, (col0 + bj * HALF) * 4); bb[bj][1] = *GPC(f32x4, bias, (col0 + bj * HALF + 4) * 4); }
#pragma unroll
        for (int bj = 0; bj < 2; ++bj) {
            const f32x4 b0 = bb[bj][0], b1 = bb[bj][1];
#pragma unroll
            for (int ai = 0; ai < 2; ++ai)
#pragma unroll
                for (int m = 0; m < 4; ++m) { const f32x4 v0 = acc[ai][bj][m][0] * ascale + b0, v1 = acc[ai][bj][m][1] * ascale + b1;
                    u32x2 w; w.x = q8(sigmoid_f(v0[0])) | (q8(sigmoid_f(v0[1])) << 8) | (q8(sigmoid_f(v0[2])) << 16) | (q8(sigmoid_f(v0[3])) << 24);
                    w.y = q8(sigmoid_f(v1[0])) | (q8(sigmoid_f(v1[1])) << 8) | (q8(sigmoid_f(v1[2])) << 16) | (q8(sigmoid_f(v1[3])) << 24);
                    *GP(u32x2, O, ooff + (unsigned)(ai * HALF + m * 16) * NPROJ + bj * HALF) = w;
                    asm volatile("" ::: "memory"); }
        }
    }
};
struct EpiMerge {
    static constexpr bool PERM = true;
    static constexpr bool HOOK = true;
    const unsigned char* Gt; bf16* O;
    static __device__ __forceinline__ void dec(unsigned w, f32x4& o) { o = (f32x4){fmaxf((float)(w & 0xffu), 1.f), fmaxf((float)((w >> 8) & 0xffu), 1.f), fmaxf((float)((w >> 16) & 0xffu), 1.f), fmaxf((float)(w >> 24), 1.f)}; }
    __device__ __forceinline__ void ldg(unsigned base, u32x2 (&g)[4][2]) const { unsigned o_ = base;
#pragma unroll
        for (int m = 0; m < 4; ++m) { asm volatile("" : "+v"(o_)); g[m][0] = *GPC(u32x2, Gt, o_); g[m][1] = *GPC(u32x2, Gt, o_ + HALF); o_ += 16u * NPROJ; } }
    __device__ __forceinline__ void hook(f32x4 (&acc)[2][2][4][2], const Unit& u, int t, int wr, int wc, int fr, int fq) const {
        const int row0 = u.pm * BM + wr * 64 + fr, col0 = u.pn * BM + wc * 32 + 8 * fq; const int br = (t == 4) ? 0 : 1;
        const unsigned goff = (unsigned)row0 * NPROJ + (unsigned)(br * D + col0);
        u32x2 g[2][4][2], h[2][4][2];
#pragma unroll
        for (int ai = 0; ai < 2; ++ai) { ldg(goff + (unsigned)(ai * HALF) * NPROJ, g[ai]); ldg(goff + (unsigned)D + (unsigned)(ai * HALF) * NPROJ, h[ai]); }
        __builtin_amdgcn_sched_barrier(0);
#pragma unroll
        for (int ai = 0; ai < 2; ++ai)
#pragma unroll
            for (int m = 0; m < 4; ++m)
#pragma unroll
                for (int bj = 0; bj < 2; ++bj) { f32x4 a0, a1, b0, b1; dec(g[ai][m][bj].x, a0); dec(g[ai][m][bj].y, a1); dec(h[ai][m][bj].x, b0); dec(h[ai][m][bj].y, b1);
#pragma unroll
                    for (int j = 0; j < 4; ++j) { a0[j] *= __builtin_amdgcn_rcpf(b0[j]); a1[j] *= __builtin_amdgcn_rcpf(b1[j]); }
                    acc[ai][bj][m][0] *= a0; acc[ai][bj][m][1] *= a1; }
    }
    __device__ __forceinline__ void operator()(const f32x4 (&acc)[2][2][4][2], const Unit& u, int wr, int wc, int fr, int fq, int tid) const {
        const int row0 = u.pm * BM + wr * 64 + fr, col0 = u.pn * BM + wc * 32 + 8 * fq;
        const unsigned goff = (unsigned)row0 * NPROJ + (unsigned)(2 * D + col0), ooff = (unsigned)row0 * (D * 2) + (unsigned)col0 * 2;
        u32x2 g[2][4][2];
#pragma unroll
        for (int ai = 0; ai < 2; ++ai) ldg(goff + (unsigned)(ai * HALF) * NPROJ, g[ai]);
        __builtin_amdgcn_sched_barrier(0);
#pragma unroll
        for (int ai = 0; ai < 2; ++ai) { unsigned oo_ = ooff + (unsigned)(ai * HALF) * (D * 2);
#pragma unroll
            for (int m = 0; m < 4; ++m) { asm volatile("" : "+v"(oo_));
#pragma unroll
                for (int bj = 0; bj < 2; ++bj) { f32x4 a0, a1; dec(g[ai][m][bj].x, a0); dec(g[ai][m][bj].y, a1); constexpr float I255 = 1.f / 255.f;
                    const f32x4 v0 = acc[ai][bj][m][0] * (a0 * I255), v1 = acc[ai][bj][m][1] * (a1 * I255);
                    u32x4 w; w.x = cvt_pk_bf16(v0[0], v0[1]); w.y = cvt_pk_bf16(v0[2], v0[3]); w.z = cvt_pk_bf16(v1[0], v1[1]); w.w = cvt_pk_bf16(v1[2], v1[3]);
                    *GP(u32x4, O, oo_ + bj * 256) = w; }
                oo_ += 16u * (D * 2); } }
    }
};
struct EpiF32 {
    static constexpr bool PERM = false;
    static constexpr bool HOOK = false;
    float* C;
    __device__ __forceinline__ void operator()(const f32x4 (&acc)[2][2][4][2], const Unit& u, int wr, int wc, int fr, int fq, int tid) const {
        const int row0 = u.pm * BM + wr * 64 + fr, col0 = u.pn * BM + wc * 32 + 4 * fq;
        const unsigned ooff = (unsigned)row0 * (D * 4) + (unsigned)col0 * 4;
#pragma unroll
        for (int ai = 0; ai < 2; ++ai)
#pragma unroll
            for (int m = 0; m < 4; ++m) { f32x4* rowp = GP(f32x4, C, ooff + (unsigned)(ai * HALF + m * 16) * (D * 4));
#pragma unroll
                for (int bj = 0; bj < 2; ++bj)
#pragma unroll
                    for (int n = 0; n < 2; ++n) rowp[bj * 32 + n * 4] = acc[ai][bj][m][n]; }
    }
};
struct EpiSwiglu {
    static constexpr bool PERM = true;
    static constexpr bool HOOK = false;
    unsigned char* Hd; float ascale;
    __device__ __forceinline__ void operator()(const f32x4 (&acc)[2][2][4][2], const Unit& u, int wr, int wc, int fr, int fq, int tid) const {
        const int row0 = u.pm * BM + wr * 64 + fr, col0 = u.pn * HALF + wc * 32 + 8 * fq;
        const unsigned ooff = (unsigned)row0 * DEXP + (unsigned)col0;
#pragma unroll
        for (int ai = 0; ai < 2; ++ai)
#pragma unroll
            for (int m = 0; m < 4; ++m) {
                float h[8];
#pragma unroll
                for (int n = 0; n < 2; ++n)
#pragma unroll
                    for (int j = 0; j < 4; ++j) { const float g = acc[ai][0][m][n][j] * ascale, up = acc[ai][1][m][n][j] * ascale; h[n * 4 + j] = g * sigmoid_f(g) * up * 8.f; }
                u32x2 w; int t0 = 0, t1 = 0;
                t0 = __builtin_amdgcn_cvt_pk_fp8_f32(h[0], h[1], t0, false); t0 = __builtin_amdgcn_cvt_pk_fp8_f32(h[2], h[3], t0, true);
                t1 = __builtin_amdgcn_cvt_pk_fp8_f32(h[4], h[5], t1, false); t1 = __builtin_amdgcn_cvt_pk_fp8_f32(h[6], h[7], t1, true);
                w.x = (unsigned)t0; w.y = (unsigned)t1;
                *GP(u32x2, Hd, ooff + (unsigned)(ai * HALF + m * 16) * DEXP) = w; }
    }
};
struct EpiDown {
    static constexpr bool PERM = true;
    static constexpr bool HOOK = false;
    bf16* Y; float ascale;
    __device__ __forceinline__ void operator()(const f32x4 (&acc)[2][2][4][2], const Unit& u, int wr, int wc, int fr, int fq, int tid) const {
        const int row0 = u.pm * BM + wr * 64 + fr, col0 = u.pn * BM + wc * 32 + 8 * fq;
        const unsigned ooff = (unsigned)row0 * (D * 2) + (unsigned)col0 * 2;
#pragma unroll
        for (int ai = 0; ai < 2; ++ai)
#pragma unroll
            for (int m = 0; m < 4; ++m) { u32x4* yp = GP(u32x4, Y, ooff + (unsigned)(ai * HALF + m * 16) * (D * 2));
#pragma unroll
                for (int bj = 0; bj < 2; ++bj) { const f32x4 v0 = acc[ai][bj][m][0] * ascale, v1 = acc[ai][bj][m][1] * ascale;
                    u32x4 w; w.x = cvt_pk_bf16(v0[0], v0[1]); w.y = cvt_pk_bf16(v0[2], v0[3]); w.z = cvt_pk_bf16(v1[0], v1[1]); w.w = cvt_pk_bf16(v1[2], v1[3]);
                    yp[bj * 16] = w; } }
    }
};
}


namespace att {
typedef float f32x16 __attribute__((ext_vector_type(16)));
typedef short s16x4 __attribute__((ext_vector_type(4)));
typedef short v4i16_t __attribute__((ext_vector_type(4)));
constexpr int KV_OFF = 0, V_OFF = 65536, KM_OFF = 114688, SLOT_OFF = 114688 + 8192;
__device__ __forceinline__ unsigned off_b(unsigned row, unsigned ch) { return 256u * row + 16u * (ch ^ (((row & 3) << 2) | ((row >> 2) & 3))); }
__device__ __forceinline__ s16x4 vtr(const LAS unsigned char* p) { return __builtin_bit_cast(s16x4, __builtin_amdgcn_ds_read_tr16_b64_v4i16((LAS v4i16_t*)p)); }

__device__ __forceinline__ float xhalf_max(float v) { return fmaxf(v, __shfl_xor(v, 32)); }
__device__ __forceinline__ float xhalf_sum(float v) { return v + __shfl_xor(v, 32); }

template <int MODE>
__device__ __forceinline__ void attn_queue(LAS unsigned char* lds, const bf16* QKV, bf16* ATT, bf16* PA, float* LSEA, const float* KMEAN, const float* sinks, unsigned* qctr, const int tid) {
    const int lane = tid & 63, wave = __builtin_amdgcn_readfirstlane(tid >> 6), r32 = lane & 31, hh = lane >> 5;
    constexpr int NITEMS = (MODE == 2) ? 1024 : 768;
    LAS int* slot = (LAS int*)(lds + SLOT_OFF);
    LAS float* km = (LAS float*)(lds + KM_OFF);
    const unsigned pi = (unsigned)((r32 & 0x13) | ((r32 & 4) << 1) | ((r32 & 8) >> 1));
    const unsigned kx = ((pi & 3) << 2) | ((pi >> 2) & 3), krow = 256u * pi;
    const unsigned vq = (unsigned)((lane & 15) >> 2), vp = (unsigned)(lane & 3), vblk = (unsigned)((lane >> 4) & 1);
    unsigned vbase[2];
#pragma unroll
    for (int t_ = 0; t_ < 2; ++t_) vbase[t_] = 256u * (unsigned)(8 * hh + 4 * t_ + (int)vq) + 16u * ((2u * vblk + (vp >> 1)) ^ (unsigned)(2 * hh + t_)) + 8u * (vp & 1);
#define vcq_(c_) (64u * ((unsigned)(c_) ^ vq))
    const unsigned kz = (unsigned)hh ^ kx;
    const auto rsrc = __builtin_amdgcn_make_buffer_rsrc((void*)QKV, 0, 0xffffffff, 0x00020000);
    unsigned drow[2], dch[2];
#pragma unroll
    for (int i = 0; i < 2; ++i) { drow[i] = (unsigned)(8 * wave + 4 * i + (lane >> 4)); dch[i] = (unsigned)(lane & 15) ^ ((((unsigned)(lane >> 4) & 3u) << 2) | ((unsigned)(2 * wave + i) & 3u)); }

    __syncthreads();
    int qcur = (MODE == 1) ? (int)(__builtin_amdgcn_s_getreg((3 << 11) | 20) & 7u) : 0, qtries = 0;
    auto fetch = [&]() -> int {
        if constexpr (MODE != 1) return (int)__hip_atomic_fetch_add(qctr, 1u, __ATOMIC_RELAXED, __HIP_MEMORY_SCOPE_AGENT);
        else { for (;;) { if (qtries >= 8) return NITEMS; const int idx = (int)__hip_atomic_fetch_add(qctr + 16 * qcur, 1u, __ATOMIC_RELAXED, __HIP_MEMORY_SCOPE_AGENT);
                          if (idx < 96) return qcur * 96 + idx; qcur = (qcur + 1) & 7; ++qtries; } } };
    if (tid == 0) slot[0] = fetch();
    LDS_WAIT(); __syncthreads();
    int item = slot[0];
    while (item < NITEMS) {
        int nxt_local = 0;
        if (tid == 0) nxt_local = fetch();
        int b, khead, ntiles, dil = 1, res = 0, m0 = 0, nblk = 0, hB = 0, grp = 0;
        int qhead;
        if constexpr (MODE == 0) { const int sub = item & 15, bh = item >> 4; b = bh / 6; const int head = bh - 6 * b; grp = head >> 1; dil = (grp == 0) ? 1 : (grp == 1 ? 4 : 16);
            const int per = 16 / dil; res = sub / per; m0 = (sub - res * per) * 256; khead = head; qhead = head; ntiles = 6; }
        else if constexpr (MODE == 1) { const int qq = item / 96, qi = item - 96 * qq; const int bh = qq * 6 + (qi >> 4); nblk = 15 - (qi & 15); b = bh / 6; hB = bh - 6 * b; khead = 6 + hB; qhead = 6 + hB; ntiles = 4 * (nblk + 1); }
        else { const int pt = item & 63, bk = item >> 6; b = bk >> 1; const int kvh = bk & 1; m0 = pt * 64; khead = 12 + kvh; qhead = 12 + kvh * 4 + (wave >> 1); ntiles = 3; }
        int qidx, qtok;
        if constexpr (MODE == 0) { qidx = m0 + 32 * wave + r32; qtok = b * SEQ + res + qidx * dil; }
        else if constexpr (MODE == 1) { qidx = 256 * nblk + 32 * wave + r32; qtok = b * SEQ + qidx; }
        else { qidx = m0 + 32 * (wave & 1) + r32; qtok = b * SEQ + qidx; }
        const int q0w = qidx - r32;
        bf16x8 qf[8];
        { const bf16* qp = QKV + (size_t)qtok * NPROJ + qhead * HD + hh * 8;
#pragma unroll
          for (int ks = 0; ks < 8; ++ks) qf[ks] = *(const bf16x8*)(qp + 16 * ks); }
        auto tile_k0 = [&](int ts) -> int {
            if constexpr (MODE == 0) return m0 - 128 + 64 * (5 - ts);
            else if constexpr (MODE == 1) return 256 * (nblk - (ts >> 2)) + 64 * (3 - (ts & 3));
            else return m0 - 128 + 64 * (2 - ts); };
        const unsigned dvo0 = drow[0] * (unsigned)(dil * NPROJ * 2) + 16u * dch[0], dvo1 = drow[1] * (unsigned)(dil * NPROJ * 2) + 16u * dch[1];
        auto dma = [&](int ts, int sl, bool isv) {
            int k0 = tile_k0(ts); k0 = k0 < 0 ? 0 : k0;
            const unsigned so = (unsigned)(b * SEQ + res + k0 * dil) * (unsigned)(NPROJ * 2) + (unsigned)(((isv ? VOFF : KOFF) + khead * HD) * 2);
            LAS unsigned char* dst = lds + KV_OFF + (isv ? V_OFF : 0) + sl * 16384 + wave * 2048;
            __builtin_amdgcn_raw_ptr_buffer_load_lds(rsrc, (LAS void*)dst, 16, (int)dvo0, (int)so, 0, 0);
            __builtin_amdgcn_raw_ptr_buffer_load_lds(rsrc, (LAS void*)(dst + 1024), 16, (int)dvo1, (int)so, 0, 0); };
        dma(0, 0, false); if (ntiles > 1) { dma(1, 1, false); dma(1, 1, true); } if (ntiles > 2) dma(2, 2, false); dma(0, 0, true);
        unsigned selmask = 0u;
        if constexpr (MODE == 1) {
            { const int j = tid >> 5, c = tid & 31; const f32x4* kq = (const f32x4*)(KMEAN + (size_t)((b * 16 + j) * 6 + hB) * 4 * HD + c * 4);
              *(LAS f32x4*)(km + j * 128 + c * 4) = (kq[0] + kq[32]) + (kq[64] + kq[96]); }
            LDS_WAIT(); __syncthreads();
            float v1 = -INFINITY, v2 = -INFINITY, v3 = -INFINITY; int i1 = -1, i2 = -1, i3 = -1;
            for (int j = 0; j < nblk; ++j) {
                float a = 0.f;
#pragma unroll
                for (int ks = 0; ks < 8; ++ks) { const f32x4 k0 = *(const LAS f32x4*)(km + j * 128 + 16 * ks + 8 * hh), k1 = *(const LAS f32x4*)(km + j * 128 + 16 * ks + 8 * hh + 4);
                    const u32x4 qq = __builtin_bit_cast(u32x4, qf[ks]);
                    a += bflo(qq.x) * k0[0] + bfhi(qq.x) * k0[1] + bflo(qq.y) * k0[2] + bfhi(qq.y) * k0[3] + bflo(qq.z) * k1[0] + bfhi(qq.z) * k1[1] + bflo(qq.w) * k1[2] + bfhi(qq.w) * k1[3]; }
                a = xhalf_sum(a);
                if (a > v1) { v3 = v2; i3 = i2; v2 = v1; i2 = i1; v1 = a; i1 = j; }
                else if (a > v2) { v3 = v2; i3 = i2; v2 = a; i2 = j; }
                else if (a > v3) { v3 = a; i3 = j; }
            }
            if (i1 >= 0) selmask |= 1u << i1; if (i2 >= 0) selmask |= 1u << i2; if (i3 >= 0) selmask |= 1u << i3;
        }
        auto params = [&](int ts, bool& active, int& dl, int& dmax, bool& pastb) {
            const int k0 = tile_k0(ts); pastb = false;
            if constexpr (MODE == 1) {
                const int kblk = nblk - (ts >> 2);
                if (kblk == nblk) { active = k0 <= q0w + 31; dl = qidx - (k0 + 8 * hh); dmax = 0x7fffffff; }
                else { const bool sel = (selmask >> kblk) & 1u; active = __ballot(sel) != 0ull; dl = 64; dmax = sel ? 0x7fffffff : 0; pastb = true; }
            } else {
                constexpr int MAXD = (MODE == 0) ? 128 : 127;
                active = (k0 <= q0w + 31) && (k0 + 63 >= q0w - MAXD) && (k0 + 63 >= 0);
                dl = qidx - (k0 + 8 * hh); dmax = qidx < MAXD ? qidx : MAXD;
            } };
        float m_run = -1e30f, l_run = 0.f; f32x16 o[4];
#pragma unroll
        for (int c = 0; c < 4; ++c)
#pragma unroll
            for (int i = 0; i < 16; ++i) o[c][i] = 0.f;
        f32x16 sc; bool act_c = false, act_n = false, pb_c = false, pb_n = false; int dl_c = 0, dmax_c = 0, dl_n = 0, dmax_n = 0;
#pragma unroll
        for (int i = 0; i < 16; ++i) sc[i] = 0.f;
#define ATT_QK(sn, Kb_, half_) do { bf16x8 kf[3]; f32x16 z_; \
            _Pragma("unroll") for (int i_ = 0; i_ < 16; ++i_) z_[i_] = 0.f; \
            _Pragma("unroll") for (int ks_ = 0; ks_ < 3; ++ks_) kf[ks_] = *(const LAS bf16x8*)((Kb_) + 8192 * (half_) + krow + 16u * ((unsigned)(2 * ks_) ^ kz)); \
            __builtin_amdgcn_sched_barrier(0); __builtin_amdgcn_s_setprio(1);        \
            _Pragma("unroll") for (int ks_ = 0; ks_ < 8; ++ks_) { sn = __builtin_amdgcn_mfma_f32_32x32x16_bf16(kf[ks_ % 3], qf[ks_], ks_ == 0 ? z_ : sn, 0, 0, 0); \
                if (ks_ + 3 < 8) kf[ks_ % 3] = *(const LAS bf16x8*)((Kb_) + 8192 * (half_) + krow + 16u * ((unsigned)(2 * (ks_ + 3)) ^ kz)); \
                __builtin_amdgcn_sched_barrier(0); } \
            __builtin_amdgcn_s_setprio(0); } while (0)
#define VTR_ASM(dst_, addr_, OFF_) asm volatile("ds_read_b64_tr_b16 %0, %1 offset:%2" : "=v"(dst_) : "v"(addr_), "n"(OFF_))
#define VTR_WAIT(n_, a_, b_) asm volatile("s_waitcnt lgkmcnt(" #n_ ")" : "+v"(a_), "+v"(b_))
#define ATT_SMPV(Vb_, half_) do { \
            const bool lout_ = (MODE == 1) && pb_c && (dmax_c == 0);        \
            if (MODE != 1 || !pb_c) { const bool fullv_ = (dl_c >= 55) && ((unsigned)dl_c <= (unsigned)dmax_c); \
              if (!__all(fullv_)) { _Pragma("unroll") for (int i_ = 0; i_ < 16; ++i_) { const int c0_ = 32 * (half_) + 16 * (i_ >> 3) + (i_ & 7); sc[i_] = ((unsigned)(dl_c - c0_) <= (unsigned)dmax_c) ? sc[i_] : -INFINITY; } } } \
            float mx_ = sc[0]; _Pragma("unroll") for (int i_ = 1; i_ < 16; ++i_) mx_ = fmaxf(mx_, sc[i_]);        \
            mx_ = lout_ ? -INFINITY : mx_; \
            if (!__all(mx_ - m_run <= 8.f)) { mx_ = xhalf_max(mx_);        \
                const float mn_ = fmaxf(m_run, mx_), al_ = __builtin_amdgcn_exp2f(m_run - mn_); m_run = mn_; l_run *= al_; \
                _Pragma("unroll") for (int c_ = 0; c_ < 4; ++c_) _Pragma("unroll") for (int i_ = 0; i_ < 16; ++i_) o[c_][i_] *= al_; } \
            const float mu_ = lout_ ? INFINITY : m_run;        \
            float ps_ = 0.f; _Pragma("unroll") for (int i_ = 0; i_ < 16; ++i_) { sc[i_] = __builtin_amdgcn_exp2f(sc[i_] - mu_); ps_ += sc[i_]; } l_run += ps_; \
            bf16x8 pk_[2]; _Pragma("unroll") for (int st_ = 0; st_ < 2; ++st_) { u32x4 w_; w_.x = cvt_pk_bf16(sc[8 * st_ + 0], sc[8 * st_ + 1]); w_.y = cvt_pk_bf16(sc[8 * st_ + 2], sc[8 * st_ + 3]); \
                w_.z = cvt_pk_bf16(sc[8 * st_ + 4], sc[8 * st_ + 5]); w_.w = cvt_pk_bf16(sc[8 * st_ + 6], sc[8 * st_ + 7]); pk_[st_] = __builtin_bit_cast(bf16x8, w_); } \
            const unsigned vbu_ = (unsigned)(__UINTPTR_TYPE__)(Vb_); \
            s16x4 va_[4][2]; unsigned vad_[4][2]; \
            _Pragma("unroll") for (int e_ = 0; e_ < 4; ++e_) _Pragma("unroll") for (int tt_ = 0; tt_ < 2; ++tt_) vad_[e_][tt_] = vbu_ + vbase[tt_] + vcq_(e_); \
            _Pragma("unroll") for (int e_ = 0; e_ < 4; ++e_) _Pragma("unroll") for (int tt_ = 0; tt_ < 2; ++tt_) VTR_ASM(va_[e_][tt_], vad_[e_][tt_], 4096 * (2 * (half_))); \
            __builtin_amdgcn_sched_barrier(0); __builtin_amdgcn_s_setprio(1); \
            _Pragma("unroll") for (int e_ = 0; e_ < 8; ++e_) { const int c_ = e_ & 3; \
                if (e_ < 5) VTR_WAIT(6, va_[e_ & 3][0], va_[e_ & 3][1]); else if (e_ == 5) VTR_WAIT(4, va_[e_ & 3][0], va_[e_ & 3][1]); \
                else if (e_ == 6) VTR_WAIT(2, va_[e_ & 3][0], va_[e_ & 3][1]); else VTR_WAIT(0, va_[e_ & 3][0], va_[e_ & 3][1]); \
                const s16x4 a0_ = va_[e_ & 3][0], a1_ = va_[e_ & 3][1]; \
                bf16x8 vf_; vf_[0] = a0_[0]; vf_[1] = a0_[1]; vf_[2] = a0_[2]; vf_[3] = a0_[3]; vf_[4] = a1_[0]; vf_[5] = a1_[1]; vf_[6] = a1_[2]; vf_[7] = a1_[3]; \
                o[c_] = __builtin_amdgcn_mfma_f32_32x32x16_bf16(vf_, pk_[e_ >> 2], o[c_], 0, 0, 0); \
                if (e_ + 4 < 8) { _Pragma("unroll") for (int tt_ = 0; tt_ < 2; ++tt_) VTR_ASM(va_[e_ & 3][tt_], vad_[e_ & 3][tt_], 4096 * (2 * (half_) + 1)); } \
                __builtin_amdgcn_sched_barrier(0); } \
            __builtin_amdgcn_s_setprio(0); } while (0)
        asm volatile("s_waitcnt vmcnt(0)" ::: "memory"); __syncthreads();
        params(0, act_c, dl_c, dmax_c, pb_c);
        if (act_c) { const LAS unsigned char* Kb = lds + KV_OFF; ATT_QK(sc, Kb, 0); }
        int k4 = 0, v3 = 0;
        for (int t = 0; t < ntiles; ++t) {
            const int k4n = (k4 + 1) & 3, v3n = (v3 == 2) ? 0 : v3 + 1;
            const bool issK = t + 3 < ntiles, issV = t + 2 < ntiles;
            if (issK) dma(t + 3, (k4 + 3) & 3, false);
            if (issV) dma(t + 2, (v3 == 0) ? 2 : v3 - 1, true);
            const LAS unsigned char* Kb = lds + KV_OFF + k4 * 16384; const LAS unsigned char* Vb = lds + KV_OFF + V_OFF + v3 * 16384;
            { f32x16 sn; if (act_c) { ATT_QK(sn, Kb, 1); ATT_SMPV(Vb, 0); sc = sn; } }
            { f32x16 sn;
#pragma unroll
              for (int i = 0; i < 16; ++i) sn[i] = 0.f;
              act_n = false;
              if (t + 1 < ntiles) { params(t + 1, act_n, dl_n, dmax_n, pb_n); if (act_n) { const LAS unsigned char* Kn = lds + KV_OFF + k4n * 16384; ATT_QK(sn, Kn, 0); } }
              if (act_c) { ATT_SMPV(Vb, 1); }
              sc = sn; act_c = act_n; dl_c = dl_n; dmax_c = dmax_n; pb_c = pb_n; }
            k4 = k4n; v3 = v3n;
            if (issK && issV) asm volatile("s_waitcnt vmcnt(4)" ::: "memory"); else asm volatile("s_waitcnt vmcnt(0)" ::: "memory");
            LDS_WAIT(); __builtin_amdgcn_s_barrier();
        }
#undef ATT_QK
#undef ATT_SMPV

        { const float l = xhalf_sum(l_run); const float lse2 = m_run + log2f(l); float sc = 1.f / l; bf16* orow;
          if constexpr (MODE == 0) { orow = PA + ((size_t)grp * T + qtok) * 256 + (qhead & 1) * HD; if (hh == 0) LSEA[((size_t)grp * T + qtok) * 2 + (qhead & 1)] = lse2; }
          else if constexpr (MODE == 1) { orow = ATT + (size_t)qtok * D + 256 + hB * HD; }
          else { const int qh = qhead - 12; orow = ATT + (size_t)qtok * D + 1024 + qh * HD; sc *= 1.f / (1.f + expf(sinks[qh] - lse2 * LN2F)); }
          bf16* const orow16 = orow + 8 * hh;
#pragma unroll
          for (int c = 0; c < 4; ++c)
#pragma unroll
              for (int p = 0; p < 2; ++p) { const int g0 = 2 * p, g1 = 2 * p + 1;
                  const unsigned ax = cvt_pk_bf16(o[c][4 * g0] * sc, o[c][4 * g0 + 1] * sc), ay = cvt_pk_bf16(o[c][4 * g0 + 2] * sc, o[c][4 * g0 + 3] * sc);
                  const unsigned bx_ = cvt_pk_bf16(o[c][4 * g1] * sc, o[c][4 * g1 + 1] * sc), by_ = cvt_pk_bf16(o[c][4 * g1 + 2] * sc, o[c][4 * g1 + 3] * sc);
                  const auto rx = __builtin_amdgcn_permlane32_swap(ax, bx_, false, false); const auto ry = __builtin_amdgcn_permlane32_swap(ay, by_, false, false);
                  u32x4 w; w.x = rx[0]; w.y = ry[0]; w.z = rx[1]; w.w = ry[1];
                  *(u32x4*)(orow16 + 32 * c + 16 * p) = w; } }
        if (tid == 0) slot[0] = nxt_local;
        LDS_WAIT(); __syncthreads();
        item = slot[0];
    }
}
}

#define XB_TMO      128
#define XB_XCNT(j)  (256  + 64 * (j))
#define XB_XSUB(j)  (1280 + 64 * (j))
#define XB_XGEN(j)  (2304 + 64 * (j))
#define XB_TOP      3328
#define XB_TOPGEN   3392
#define XCD_BAR_WORDS 3456
#define XB_SPIN_CAP (1u << 18)
__device__ __forceinline__ unsigned xb_ld(unsigned* p)              { return __hip_atomic_load(p, __ATOMIC_RELAXED, __HIP_MEMORY_SCOPE_AGENT); }
__device__ __forceinline__ unsigned xb_add(unsigned* p, unsigned v) { return __hip_atomic_fetch_add(p, v, __ATOMIC_RELAXED, __HIP_MEMORY_SCOPE_AGENT); }
__device__ __forceinline__ unsigned xb_xcc_id() { return (unsigned)__builtin_amdgcn_s_getreg((3 << 11) | 20) & 0xFu; }
#define XB_SPIN(cond, bar) do { unsigned _sp = 0; while (cond) { __builtin_amdgcn_s_sleep(1); \
    if ((++_sp & 255u) == 0u) { if (xb_ld(&(bar)[XB_TMO])) break; if (_sp > XB_SPIN_CAP) { atomicAdd(&(bar)[XB_TMO], 1u); break; } } } } while (0)
struct XcdBarrier { unsigned* bar; unsigned x; volatile LAS unsigned* st; };
__device__ __forceinline__ XcdBarrier xcd_barrier_post(unsigned* bar, volatile LAS unsigned* st) {
    XcdBarrier b; b.bar = bar; b.x = xb_xcc_id(); b.st = st;
    if (threadIdx.x == 0) (void)xb_add(&bar[XB_XCNT(b.x)], 1u);
    return b;
}
__device__ __forceinline__ void xcd_barrier_complete(unsigned* bar, unsigned x, unsigned& nloc, unsigned& nx) {
    const unsigned G = gridDim.x * gridDim.y * gridDim.z;
    unsigned sum, cnt, mine, sp = 0u;
    for (;;) {
        sum = 0u; cnt = 0u; mine = 0u;
#pragma unroll
        for (unsigned j = 0; j < 16; ++j) { const unsigned c = xb_ld(&bar[XB_XCNT(j)]); sum += c; cnt += (c > 0u) ? 1u : 0u; mine = (j == x) ? c : mine; }
        if (sum == G) break;
        __builtin_amdgcn_s_sleep(1);
        if ((++sp & 255u) == 0u) { if (xb_ld(&bar[XB_TMO])) break; if (sp > XB_SPIN_CAP) { atomicAdd(&bar[XB_TMO], 1u); break; } }
    }
    nloc = mine > 0u ? mine : 1u; nx = cnt > 0u ? cnt : 1u;
}
__device__ __forceinline__ void xcd_barrier(const XcdBarrier& b) {
    asm volatile("s_waitcnt vmcnt(0)" ::: "memory");
    __syncthreads();
    if (threadIdx.x == 0) {
        unsigned* bar = b.bar;
        __builtin_amdgcn_s_waitcnt(0);
        unsigned nloc = b.st[0], nx = b.st[1];
        if (nloc == 0u) { xcd_barrier_complete(bar, b.x, nloc, nx); b.st[0] = nloc; b.st[1] = nx; }
        const unsigned old = xb_add(&bar[XB_XSUB(b.x)], 1u);
        const unsigned gen = old / nloc;
        if (old + 1u == (gen + 1u) * nloc) {
            __builtin_amdgcn_fence(__ATOMIC_RELEASE, "agent");
            asm volatile("s_waitcnt vmcnt(0)" ::: "memory");
            const unsigned og = xb_add(&bar[XB_TOP], 1u);
            const unsigned tg = og / nx;
            if (og + 1u == (tg + 1u) * nx) xb_add(&bar[XB_TOPGEN], 1u);
            else XB_SPIN(xb_ld(&bar[XB_TOPGEN]) == tg, bar);
            __builtin_amdgcn_fence(__ATOMIC_ACQUIRE, "agent");
            xb_add(&bar[XB_XGEN(b.x)], 1u);
            asm volatile("s_waitcnt vmcnt(0)" ::: "memory");
        } else {
            XB_SPIN(xb_ld(&bar[XB_XGEN(b.x)]) == gen, bar);
            __builtin_amdgcn_fence(__ATOMIC_ACQUIRE, "agent");
            asm volatile("s_waitcnt vmcnt(0)" ::: "memory");
        }
    }
    __syncthreads();
}

#define dpp_f(v, ctrl) __builtin_bit_cast(float, __builtin_amdgcn_update_dpp(0, __builtin_bit_cast(int, (float)(v)), (ctrl), 0xf, 0xf, true))
__device__ __forceinline__ float wave_sum(float v) {
    v += __builtin_bit_cast(float, __builtin_amdgcn_update_dpp(0, __builtin_bit_cast(int, v), 0xB1, 0xf, 0xf, true));
    v += __builtin_bit_cast(float, __builtin_amdgcn_update_dpp(0, __builtin_bit_cast(int, v), 0x4E, 0xf, 0xf, true));
    v += __builtin_bit_cast(float, __builtin_amdgcn_update_dpp(0, __builtin_bit_cast(int, v), 0x141, 0xf, 0xf, true));
    v += __builtin_bit_cast(float, __builtin_amdgcn_update_dpp(0, __builtin_bit_cast(int, v), 0x140, 0xf, 0xf, true));
    const int iv = __builtin_bit_cast(int, v);
    const float r0 = __builtin_bit_cast(float, __builtin_amdgcn_readlane(iv, 0)), r1 = __builtin_bit_cast(float, __builtin_amdgcn_readlane(iv, 16));
    const float r2 = __builtin_bit_cast(float, __builtin_amdgcn_readlane(iv, 32)), r3 = __builtin_bit_cast(float, __builtin_amdgcn_readlane(iv, 48));
    return (r0 + r1) + (r2 + r3);
}
__device__ __forceinline__ float wave_max(float v) {
#pragma unroll
    for (int o = 1; o < 64; o <<= 1) v = fmaxf(v, __shfl_xor(v, o));
    return v;
}

__device__ __forceinline__ void transpose_item(const float* W, int ldw, bf16* WT, int ldt, int k0, int n0, int dst_row0, LAS float* scr, int lane) {
#pragma unroll 8
    for (int i = 0; i < 32; ++i) { const int kk = 2 * i + (lane >> 5); scr[kk * 33 + (lane & 31)] = W[(size_t)(k0 + kk) * ldw + n0 + (lane & 31)]; }
    LDS_WAIT(); asm volatile("" ::: "memory");
    const int c = lane & 7;
#pragma unroll
    for (int j = 0; j < 4; ++j) { const int n = (lane >> 3) + 8 * j; const LAS float* s = scr + (8 * c) * 33 + n;
        u32x4 o; o.x = pk2(s[0 * 33], s[1 * 33]); o.y = pk2(s[2 * 33], s[3 * 33]); o.z = pk2(s[4 * 33], s[5 * 33]); o.w = pk2(s[6 * 33], s[7 * 33]);
        *(u32x4*)(WT + (size_t)(dst_row0 + n) * ldt + k0 + 8 * c) = o; }
    LDS_WAIT(); asm volatile("" ::: "memory");
}

__device__ __forceinline__ void transpose_item8(const float* W, int ldw, unsigned char* WT, int ldt, int k0, int n0, int dst_row0, LAS float* scr, int lane) {
#pragma unroll 8
    for (int i = 0; i < 32; ++i) { const int kk = 2 * i + (lane >> 5); scr[kk * 33 + (lane & 31)] = W[(size_t)(k0 + kk) * ldw + n0 + (lane & 31)]; }
    LDS_WAIT(); asm volatile("" ::: "memory");
    const int c = lane & 3;
#pragma unroll
    for (int j = 0; j < 2; ++j) { const int n = (lane >> 2) + 16 * j; const LAS float* sp = scr + (16 * c) * 33 + n;
        int w[4];
#pragma unroll
        for (int q = 0; q < 4; ++q) { int t = 0; t = __builtin_amdgcn_cvt_pk_fp8_f32(sp[(4 * q) * 33] * W8_SCALE, sp[(4 * q + 1) * 33] * W8_SCALE, t, false);
            t = __builtin_amdgcn_cvt_pk_fp8_f32(sp[(4 * q + 2) * 33] * W8_SCALE, sp[(4 * q + 3) * 33] * W8_SCALE, t, true); w[q] = t; }
        u32x4 o; o.x = (unsigned)w[0]; o.y = (unsigned)w[1]; o.z = (unsigned)w[2]; o.w = (unsigned)w[3];
        *(u32x4*)(WT + (size_t)(dst_row0 + n) * ldt + k0 + 16 * c) = o; }
    LDS_WAIT(); asm volatile("" ::: "memory");
}


struct WItem { const float* W; int ldw; unsigned char* WT; int ldt; int k0, n0, dst_row0; int f8; };
__device__ __forceinline__ void witem_issue(const WItem& I, float (&r)[32], int lane) {
    const float* p = I.W + (size_t)(I.k0 + (lane >> 5)) * I.ldw + I.n0 + (lane & 31);
#pragma unroll
    for (int i = 0; i < 32; ++i) r[i] = __builtin_nontemporal_load(p + (size_t)(2 * i) * I.ldw);
}
__device__ __forceinline__ void witem_finish(const WItem& I, const float (&r)[32], LAS float* scr, int lane) {
#pragma unroll
    for (int i = 0; i < 32; ++i) { const int kk = 2 * i + (lane >> 5); scr[kk * 33 + (lane & 31)] = r[i]; }
    LDS_WAIT(); asm volatile("" ::: "memory");
    if (I.f8) {
        const int c = lane & 3;
#pragma unroll
        for (int j = 0; j < 2; ++j) { const int n = (lane >> 2) + 16 * j; const LAS float* sp = scr + (16 * c) * 33 + n;
            int w[4];
#pragma unroll
            for (int q = 0; q < 4; ++q) { int t = 0; t = __builtin_amdgcn_cvt_pk_fp8_f32(sp[(4 * q) * 33] * W8_SCALE, sp[(4 * q + 1) * 33] * W8_SCALE, t, false);
                t = __builtin_amdgcn_cvt_pk_fp8_f32(sp[(4 * q + 2) * 33] * W8_SCALE, sp[(4 * q + 3) * 33] * W8_SCALE, t, true); w[q] = t; }
            u32x4 o; o.x = (unsigned)w[0]; o.y = (unsigned)w[1]; o.z = (unsigned)w[2]; o.w = (unsigned)w[3];
            *(u32x4*)(I.WT + (size_t)(I.dst_row0 + n) * I.ldt + I.k0 + 16 * c) = o; }
    } else {
        const int c = lane & 7; bf16* WTb = (bf16*)I.WT;
#pragma unroll
        for (int j = 0; j < 4; ++j) { const int n = (lane >> 3) + 8 * j; const LAS float* sq = scr + (8 * c) * 33 + n;
            u32x4 o; o.x = pk2(sq[0 * 33], sq[1 * 33]); o.y = pk2(sq[2 * 33], sq[3 * 33]); o.z = pk2(sq[4 * 33], sq[5 * 33]); o.w = pk2(sq[6 * 33], sq[7 * 33]);
            *(u32x4*)(WTb + (size_t)(I.dst_row0 + n) * I.ldt + I.k0 + 8 * c) = o; }
    }
    LDS_WAIT(); asm volatile("" ::: "memory");
}

struct Args {
    const float* x; const int* pos; const float* w_in; const float* w_gate; const float* b_gate; const float* w_br_a; const float* w_br_b; const float* w_br_c;
    const float* w_out; const float* sinks; const float* ln1_g; const float* ln1_b; const float* w_rg; const float* w_re; const float* w_eg; const float* w_eu; const float* w_ed;
    const float* ln2_g; const float* ln2_b; float* out; unsigned char* ws; int ph_lo, ph_hi, li, pad;
};

__global__ void __launch_bounds__(512, 2) mega_fwd(Args args) {
    extern __shared__ __attribute__((aligned(16))) unsigned char lds_raw[];
    LAS unsigned char* lds = (LAS unsigned char*)lds_raw;
    volatile LAS unsigned* MISC = (volatile LAS unsigned*)(lds + MISC_OFF);
    const int tid0 = threadIdx.x;
    const int wave0_ = __builtin_amdgcn_readfirstlane(tid0 >> 6);
    typedef const __attribute__((address_space(4))) Args CArgs;
    CArgs* ka0 = (CArgs*)__builtin_amdgcn_kernarg_segment_ptr();
#define KA() ({ CArgs* _p = ka0; asm volatile("" : "+s"(_p)); _p; })
    unsigned char* ws0 = KA()->ws;
    unsigned* ctl = (unsigned*)(ws0 + WS_CTL);
    for (int u = tid0; u < (LDS_BYTES - LDSCTL_OFF) / 4; u += 512) ((LAS unsigned*)(lds + LDSCTL_OFF))[u] = 0u;
    __syncthreads();
#if MK_ONE_LAUNCH
    XcdBarrier bar = xcd_barrier_post(ctl + CW_BAR + KA()->li * XCD_BAR_WORDS, MISC + 8);
#define GRID_BAR() xcd_barrier(bar)
#else
#define GRID_BAR() do { if (tid0 == 0) __hip_atomic_store(ctl + 0, 0xBADBA0u, __ATOMIC_RELAXED, __HIP_MEMORY_SCOPE_AGENT); } while (0)
#endif
    const int lo = KA()->ph_lo, hi = KA()->ph_hi;
#ifndef PHSEL
#define PHSEL 0x1FFF
#endif
#define IN(k) (((PHSEL >> ((k) % NPH)) & 1) && lo <= (k) && (k) < hi)
#define SEAM(k) do { if (IN(k) && IN((k) + 1)) GRID_BAR(); } while (0)

#define PHASE_PTRS() unsigned z0_ = 0u; asm volatile("" : "+v"(z0_)); int tid = wave0_ * 64 + (int)__builtin_amdgcn_mbcnt_hi(~0u, __builtin_amdgcn_mbcnt_lo(~0u, z0_)); const int lane = tid & 63, wave = __builtin_amdgcn_readfirstlane(tid >> 6); (void)lane; (void)wave; \
    int bx = blockIdx.x; asm volatile("" : "+s"(bx)); int G = gridDim.x; asm volatile("" : "+s"(G)); \
    const int vcu = (G % 8 == 0) ? (bx % 8) * (G / 8) + bx / 8 : bx; const int gw = vcu * 8 + wave, NGW = G * 8; (void)gw; (void)NGW; \
    CArgs* const A_ = KA(); unsigned char* const ws = A_->ws; (void)ws; \
    bf16* const Wb = (bf16*)(ws + WS_W); bf16* const HB = (bf16*)(ws + WS_HB); unsigned char* const W8 = ws + WS_W; unsigned char* const HB8 = ws + WS_HB8; unsigned char* const HID8 = ws + WS_R2; (void)W8; (void)HB8; (void)HID8; \
    bf16* const QKV = (bf16*)(ws + WS_R1); bf16* const GATES = (bf16*)(ws + WS_R1); float* const MIX = (float*)(ws + WS_R1); bf16* const YB = (bf16*)(ws + WS_R1); \
    bf16* const ATT = (bf16*)(ws + WS_R2); bf16* const HID = (bf16*)(ws + WS_R2); bf16* const MERGED = (bf16*)(ws + WS_R3); \
    float* const ROPE = (float*)(ws + WS_ROPE); \
    int* const route_e = (int*)(ws + WS_ROUTE_E); float* const route_w = (float*)(ws + WS_ROUTE_W + (size_t)l * 4 * MiB); \
    int* const row_tok = (int*)(ws + WS_ROWTOK); int* const row_dst = (int*)(ws + WS_ROWDST + (size_t)l * 4 * MiB); float* const row_w = (float*)(ws + WS_ROWW); \
    int* const cnt_wg = (int*)(ws + WS_CNTWG); int* const tile_off_g = (int*)(ws + WS_TILEOFF); float* const KMEAN = (float*)(ws + WS_KMEAN); \
    (void)Wb; (void)HB; (void)QKV; (void)GATES; (void)MIX; (void)YB; (void)ATT; (void)HID; (void)MERGED; (void)ROPE; (void)route_e; (void)route_w; (void)row_tok; (void)row_dst; (void)row_w; (void)cnt_wg; (void)tile_off_g; (void)KMEAN; \
    const float* const hin = (l == 0) ? A_->x : A_->out; (void)hin;
    if (IN(0)) { const int l = 0; PHASE_PTRS();
                for (int idx = (bx * 512 + tid); idx < T * 64; idx += G * 512) {
                    const int t = idx >> 6, i = idx & 63;
                    const float inv = (float)pow(10000.0, -(double)(2 * i) / 128.0);
                    const float ang = (float)A_->pos[t] * inv;
                    double sn, cs; sincos((double)ang, &sn, &cs);
                    ROPE[(size_t)t * 128 + i] = (float)cs; ROPE[(size_t)t * 128 + 64 + i] = (float)sn;
                }
                for (size_t i8 = (size_t)bx * 512 + tid; i8 < (size_t)T * D / 8; i8 += (size_t)G * 512) {
                    const f32x4 a = __builtin_nontemporal_load((const f32x4*)(A_->x + i8 * 8)), b = __builtin_nontemporal_load((const f32x4*)(A_->x + i8 * 8 + 4));
                    { int t0 = 0, t1 = 0; t0 = __builtin_amdgcn_cvt_pk_fp8_f32(a[0], a[1], t0, false); t0 = __builtin_amdgcn_cvt_pk_fp8_f32(a[2], a[3], t0, true);
                      t1 = __builtin_amdgcn_cvt_pk_fp8_f32(b[0], b[1], t1, false); t1 = __builtin_amdgcn_cvt_pk_fp8_f32(b[2], b[3], t1, true);
                      *(u32x2*)(HB8 + i8 * 8) = (u32x2){(unsigned)t0, (unsigned)t1}; }
                }
            }
    for (int l = 0; l < DEPTH; ++l) {
        const int pb = l * NPH;
        if (IN(pb + 0)) REP(0) { PHASE_PTRS();
            LAS float* scr = (LAS float*)(lds + wave * 16384);
            const float* w_in = A_->w_in + (size_t)l * D * NPROJ; const float* w_gate = A_->w_gate + (size_t)l * D * NPROJ;
            const float* w_a = A_->w_br_a + (size_t)l * 256 * D; const float* w_b = A_->w_br_b + (size_t)l * 768 * D; const float* w_c = A_->w_br_c + (size_t)l * 1024 * D;
            const float* w_out = A_->w_out + (size_t)l * D * D;
            const float* w_eg = A_->w_eg + (size_t)l * NEXP * D * DEXP; const float* w_eu = A_->w_eu + (size_t)l * NEXP * D * DEXP; const float* w_ed = A_->w_ed + (size_t)l * NEXP * DEXP * D;
            constexpr int I_IN = 32 * 192, I_A = 4 * 64, I_B = 12 * 64, I_C = 16 * 64, I_OUT = 32 * 64, I_E = 1024;
            constexpr int NITEMS = 2 * I_IN + I_A + I_B + I_C + I_OUT + 3 * NEXP * I_E;
            auto decode = [&](int it, WItem& I) {
                int r = it;
                if (r < I_IN) { const int kb = r / 192, nb = r % 192, n0 = nb * 32, head = n0 >> 7, d0 = n0 & 127;
                    const int rho = 256 * (head >> 1) + 128 * (d0 >> 6) + 64 * (head & 1) + (d0 & 63);
                    I = WItem{w_in, NPROJ, W8 + W8_IN, D, kb * 64, n0, rho, 1}; return; } r -= I_IN;
                if (r < I_IN) { const int kb = r / 192, nb = r % 192; I = WItem{w_gate, NPROJ, W8 + W8_GATE, D, kb * 64, nb * 32, nb * 32, 1}; return; } r -= I_IN;
                if (r < I_A) { const int kb = r / 64, nb = r % 64; I = WItem{w_a, D, (unsigned char*)(Wb + WO_BR + 0), D, kb * 64, nb * 32, nb * 32, 0}; return; } r -= I_A;
                if (r < I_B) { const int kb = r / 64, nb = r % 64; I = WItem{w_b, D, (unsigned char*)(Wb + WO_BR + 256), D, kb * 64, nb * 32, nb * 32, 0}; return; } r -= I_B;
                if (r < I_C) { const int kb = r / 64, nb = r % 64; I = WItem{w_c, D, (unsigned char*)(Wb + WO_BR + 1024), D, kb * 64, nb * 32, nb * 32, 0}; return; } r -= I_C;
                if (r < I_OUT) { const int kb = r / 64, nb = r % 64; I = WItem{w_out, D, (unsigned char*)(Wb + WO_OUT), D, kb * 64, nb * 32, nb * 32, 0}; return; } r -= I_OUT;
                if (r < NEXP * I_E) { const int e = r / I_E, q = r % I_E, kb = q / 32, nb = q % 32, j0 = nb * 32;
                    I = WItem{w_eg + (size_t)e * D * DEXP, DEXP, W8 + W8_GU + (size_t)e * 2048 * D, D, kb * 64, j0, 256 * (j0 >> 7) + (j0 & 127), 1}; return; } r -= NEXP * I_E;
                if (r < NEXP * I_E) { const int e = r / I_E, q = r % I_E, kb = q / 32, nb = q % 32, j0 = nb * 32;
                    I = WItem{w_eu + (size_t)e * D * DEXP, DEXP, W8 + W8_GU + (size_t)e * 2048 * D, D, kb * 64, j0, 256 * (j0 >> 7) + 128 + (j0 & 127), 1}; return; } r -= NEXP * I_E;
                { const int e = r / I_E, q = r % I_E, kb = q / 64, nb = q % 64;
                    I = WItem{w_ed + (size_t)e * DEXP * D, D, W8 + W8_DN + (size_t)e * D * DEXP, DEXP, kb * 64, nb * 32, nb * 32, 1}; } };
            float rc[32];
            int it = gw;
            { WItem I; decode(it < NITEMS ? it : 0, I); witem_issue(I, rc, lane); }
            while (it < NITEMS) {
                const int itn = it + NGW; float rn[32];
                { WItem I; decode(itn < NITEMS ? itn : it, I); witem_issue(I, rn, lane); }
                { WItem I; decode(it, I); witem_finish(I, rc, scr, lane); }
                it = itn;
#pragma unroll
                for (int i = 0; i < 32; ++i) rc[i] = rn[i];
            }
        }
        SEAM(pb + 0);
        if (IN(pb + 1)) REP(1) { PHASE_PTRS();
            pg8::SchedDense S{(const char*)HB8, (const char*)(W8 + W8_IN), D, D, T / 256, NPROJ / 256, G, bx, D / 128};
            pg8::EpiRope E{QKV, ROPE, W8_INV};
            pg8::gemm_phase<pg8::EpiRope, pg8::SchedDense, true, false, true>(lds, S, E, tid);
        }
        SEAM(pb + 1);
        if (IN(pb + 2)) REP(2) { PHASE_PTRS();
            for (int it4 = gw; it4 < NBATCH * 16 * 6 * 4; it4 += NGW) {
                const int qr = it4 & 3, it = it4 >> 2; const int h = it % 6, blk = (it / 6) % 16, b = it / 96;
                const bf16* kp = QKV + (size_t)(b * SEQ + blk * 256 + qr * 64 + (lane >> 5)) * NPROJ + KOFF + (6 + h) * HD + 4 * (lane & 31);
                f32x4 a = (f32x4){0.f, 0.f, 0.f, 0.f};
#pragma unroll 8
                for (int i = 0; i < 32; ++i) { const u32x2 w = *(const u32x2*)(kp + (size_t)(2 * i) * NPROJ); a += (f32x4){bflo(w.x), bfhi(w.x), bflo(w.y), bfhi(w.y)}; }
#pragma unroll
                for (int e = 0; e < 4; ++e) a[e] += __shfl_xor(a[e], 32);
                if (lane < 32) *(f32x4*)(KMEAN + ((size_t)it * 4 + qr) * HD + 4 * lane) = a * (1.f / 256.f);
            }
        }
        SEAM(pb + 2);
        if (IN(pb + 3)) REP(3) { PHASE_PTRS();
            bf16* PA = (bf16*)(ws + WS_R3); float* LSEA = (float*)(ws + WS_R3 + 64 * MiB);
            unsigned* ctl_ = (unsigned*)(ws + WS_CTL);
            if (!((ATT_NAIVE_MASK >> 1) & 1)) att::attn_queue<1>(lds, QKV, ATT, PA, LSEA, KMEAN, A_->sinks + l * 8, ctl_ + 1024 + l * 128 + rep_ * 256, tid);
            if (!((ATT_NAIVE_MASK >> 2) & 1)) att::attn_queue<2>(lds, QKV, ATT, PA, LSEA, KMEAN, A_->sinks + l * 8, ctl_ + 64 * (8 + l * 4 + 2 + 16 * rep_), tid);
            if (!((ATT_NAIVE_MASK >> 0) & 1)) att::attn_queue<0>(lds, QKV, ATT, PA, LSEA, KMEAN, A_->sinks + l * 8, ctl_ + 64 * (8 + l * 4 + 0 + 16 * rep_), tid);
#if ATT_NAIVE_MASK
            __syncthreads();
            {
            LAS float* sc = (LAS float*)(lds + wave * 6144);
            LAS float* qf = (LAS float*)(lds + wave * 6144 + 4608 + 512);
            const float* sinks = A_->sinks + l * 8;
            for (int it = gw; it < T * 16; it += NGW) {
                const int slot = it / T, t = it - slot * T, b = t / SEQ, s = t - b * SEQ;
                { const int md = slot < 2 ? 0 : (slot < 8 ? 1 : 2); if (!((ATT_NAIVE_MASK >> md) & 1)) continue; }
                auto qdot = [&](const bf16* krow) -> float {
                    const u32x4* kp = (const u32x4*)krow; float a = 0.f;
#pragma unroll
                    for (int c = 0; c < 16; ++c) { const u32x4 kv = kp[c]; const f32x4 q0 = *(const LAS f32x4*)(qf + 8 * c), q1 = *(const LAS f32x4*)(qf + 8 * c + 4);
                        a += bflo(kv.x) * q0[0] + bfhi(kv.x) * q0[1] + bflo(kv.y) * q0[2] + bfhi(kv.y) * q0[3] + bflo(kv.z) * q1[0] + bfhi(kv.z) * q1[1] + bflo(kv.w) * q1[2] + bfhi(kv.w) * q1[3]; }
                    return a; };
                auto load_q = [&](int qh) { const unsigned w = *(const unsigned*)(QKV + (size_t)t * NPROJ + qh * HD + 2 * lane); qf[2 * lane] = bflo(w); qf[2 * lane + 1] = bfhi(w); LDS_WAIT(); };
                float o0 = 0.f, o1 = 0.f;
                if (slot < 2) {
                    float mx = -INFINITY;
                    for (int g = 0; g < 3; ++g) { const int dil = (g == 0) ? 1 : (g == 1 ? 4 : 16), head = 2 * g + slot;
                        load_q(head);
                        for (int r = 0; r < 3; ++r) { const int i = r * 64 + lane; if (i <= 128) { const int kpos = s - i * dil; float v = -INFINITY;
                                if (kpos >= 0) v = qdot(QKV + (size_t)(b * SEQ + kpos) * NPROJ + KOFF + head * HD);
                                sc[g * 129 + i] = v; mx = fmaxf(mx, v); } }
                        LDS_WAIT(); }
                    mx = wave_max(mx); float lsum = 0.f;
                    for (int i = lane; i < 387; i += 64) { const float p = exp2f(sc[i] - mx); sc[i] = p; lsum += p; }
                    lsum = wave_sum(lsum); LDS_WAIT();
                    for (int g = 0; g < 3; ++g) { const int dil = (g == 0) ? 1 : (g == 1 ? 4 : 16), head = 2 * g + slot;
                        const int imax = min(128, s / dil);
                        const bf16* vp = QKV + (size_t)(b * SEQ + s) * NPROJ + VOFF + head * HD + 2 * lane;
                        _Pragma("unroll 8") for (int i = 0; i <= imax; ++i) { const float p = sc[g * 129 + i]; const unsigned w = *(const unsigned*)(vp - (size_t)i * dil * NPROJ); o0 += p * bflo(w); o1 += p * bfhi(w); } }
                    const float inv = 1.f / lsum;
                    *(unsigned*)(ATT + (size_t)t * D + slot * HD + 2 * lane) = pk2(o0 * inv, o1 * inv);
                } else if (slot < 8) {
                    const int h = slot - 2, blk = s >> 8, head = 6 + h;
                    load_q(head);
                    float gate = -INFINITY;
                    if (lane < blk) { const f32x4* km = (const f32x4*)(KMEAN + (size_t)((b * 16 + lane) * 6 + h) * HD); float a = 0.f;
#pragma unroll 8
                        for (int c = 0; c < 32; ++c) { const f32x4 kv = km[c]; const f32x4 q0 = *(const LAS f32x4*)(qf + 4 * c); a += kv[0] * q0[0] + kv[1] * q0[1] + kv[2] * q0[2] + kv[3] * q0[3]; }
                        gate = a; }
                    int sel[3]; const int nsel = min(3, blk);
                    for (int r = 0; r < 3; ++r) { sel[r] = 0;
                        if (r < nsel) { const float mxg = wave_max(gate); const unsigned long long bal = __ballot(gate == mxg); const int w = __ffsll((long long)bal) - 1; sel[r] = w; if (lane == w) gate = -INFINITY; } }
                    float mx = -INFINITY;
                    const int nown = (s & 255) + 1;
                    for (int r = 0; r < 4; ++r) { const int i = r * 64 + lane; float v = -INFINITY;
                        if (i < nown) v = qdot(QKV + (size_t)(b * SEQ + blk * 256 + i) * NPROJ + KOFF + head * HD);
                        sc[i] = v; mx = fmaxf(mx, v); }
                    for (int q = 0; q < nsel; ++q) for (int r = 0; r < 4; ++r) { const int i = r * 64 + lane;
                        const float v = qdot(QKV + (size_t)(b * SEQ + sel[q] * 256 + i) * NPROJ + KOFF + head * HD);
                        sc[256 + q * 256 + i] = v; mx = fmaxf(mx, v); }
                    LDS_WAIT();
                    mx = wave_max(mx); float lsum = 0.f; const int ntot = 256 + nsel * 256;
                    for (int i = lane; i < ntot; i += 64) { const float p = exp2f(sc[i] - mx); sc[i] = p; lsum += p; }
                    lsum = wave_sum(lsum); LDS_WAIT();
                    { const bf16* vp = QKV + (size_t)(b * SEQ + blk * 256) * NPROJ + VOFF + head * HD + 2 * lane;
                      _Pragma("unroll 8") for (int i = 0; i < nown; ++i) { const float p = sc[i]; const unsigned w = *(const unsigned*)(vp + (size_t)i * NPROJ); o0 += p * bflo(w); o1 += p * bfhi(w); } }
                    for (int q = 0; q < nsel; ++q) { const bf16* vp = QKV + (size_t)(b * SEQ + sel[q] * 256) * NPROJ + VOFF + head * HD + 2 * lane;
                        _Pragma("unroll 16") for (int i = 0; i < 256; ++i) { const float p = sc[256 + q * 256 + i]; const unsigned w = *(const unsigned*)(vp + (size_t)i * NPROJ); o0 += p * bflo(w); o1 += p * bfhi(w); } }
                    const float inv = 1.f / lsum;
                    *(unsigned*)(ATT + (size_t)t * D + 256 + h * HD + 2 * lane) = pk2(o0 * inv, o1 * inv);
                } else {
                    const int qh = slot - 8, head_q = 12 + qh, head_kv = 12 + (qh >> 2);
                    load_q(head_q);
                    float mx = -INFINITY;
                    for (int r = 0; r < 2; ++r) { const int i = r * 64 + lane; const int kpos = s - i; float v = -INFINITY;
                        if (kpos >= 0) v = qdot(QKV + (size_t)(b * SEQ + kpos) * NPROJ + KOFF + head_kv * HD);
                        sc[i] = v; mx = fmaxf(mx, v); }
                    LDS_WAIT();
                    mx = wave_max(mx); float lsum = 0.f;
                    for (int i = lane; i < 128; i += 64) { const float p = exp2f(sc[i] - mx); sc[i] = p; lsum += p; }
                    lsum = wave_sum(lsum); LDS_WAIT();
                    const int imax = min(127, s);
                    const bf16* vp = QKV + (size_t)(b * SEQ + s) * NPROJ + VOFF + head_kv * HD + 2 * lane;
                    _Pragma("unroll 8") for (int i = 0; i <= imax; ++i) { const float p = sc[i]; const unsigned w = *(const unsigned*)(vp - (size_t)i * NPROJ); o0 += p * bflo(w); o1 += p * bfhi(w); }
                    const float lse = (mx + log2f(lsum)) * LN2F;
                    const float keep = 1.f / (1.f + expf(sinks[qh] - lse)) / lsum;
                    *(unsigned*)(ATT + (size_t)t * D + 1024 + qh * HD + 2 * lane) = pk2(o0 * keep, o1 * keep);
                }
                LDS_WAIT();
            }
            }
#endif
        }
        SEAM(pb + 3);
        if (IN(pb + 4)) REP(4) { PHASE_PTRS();
            if (!((ATT_NAIVE_MASK >> 0) & 1)) {
              const bf16* PA = (const bf16*)(ws + WS_R3); const float* LSEA = (const float*)(ws + WS_R3 + 64 * MiB);
              for (int i = bx * 512 + tid; i < T * 32; i += G * 512) { const int t = i >> 5, c8 = i & 31, j = c8 >> 4;
                  const float l0 = LSEA[(size_t)t * 2 + j], l1 = LSEA[((size_t)T + t) * 2 + j], l2 = LSEA[((size_t)2 * T + t) * 2 + j];
                  const float mx = fmaxf(l0, fmaxf(l1, l2)); float w0 = exp2f(l0 - mx), w1 = exp2f(l1 - mx), w2 = exp2f(l2 - mx); const float inv = 1.f / (w0 + w1 + w2); w0 *= inv; w1 *= inv; w2 *= inv;
                  const u32x4 a = *(const u32x4*)(PA + (size_t)t * 256 + c8 * 8), bq = *(const u32x4*)(PA + ((size_t)T + t) * 256 + c8 * 8), cq = *(const u32x4*)(PA + ((size_t)2 * T + t) * 256 + c8 * 8);
                  u32x4 o; o.x = pk2(w0 * bflo(a.x) + w1 * bflo(bq.x) + w2 * bflo(cq.x), w0 * bfhi(a.x) + w1 * bfhi(bq.x) + w2 * bfhi(cq.x));
                  o.y = pk2(w0 * bflo(a.y) + w1 * bflo(bq.y) + w2 * bflo(cq.y), w0 * bfhi(a.y) + w1 * bfhi(bq.y) + w2 * bfhi(cq.y));
                  o.z = pk2(w0 * bflo(a.z) + w1 * bflo(bq.z) + w2 * bflo(cq.z), w0 * bfhi(a.z) + w1 * bfhi(bq.z) + w2 * bfhi(cq.z));
                  o.w = pk2(w0 * bflo(a.w) + w1 * bflo(bq.w) + w2 * bflo(cq.w), w0 * bfhi(a.w) + w1 * bfhi(bq.w) + w2 * bfhi(cq.w));
                  *(u32x4*)(ATT + (size_t)t * D + c8 * 8) = o; }
            }
            pg8::SchedDense S{(const char*)HB8, (const char*)(W8 + W8_GATE), D, D, T / 256, NPROJ / 256, G, bx, D / 128};
            pg8::EpiGate E{(unsigned char*)GATES, A_->b_gate + (size_t)l * NPROJ, W8_INV};
            pg8::gemm_phase<pg8::EpiGate, pg8::SchedDense, true, false, true>(lds, S, E, tid);
        }
        SEAM(pb + 4);
        if (IN(pb + 5)) REP(5) { PHASE_PTRS();
            pg8::SchedDense S{(const char*)ATT, (const char*)(Wb + WO_BR), D * 2, D * 2, T / 256, D / 256, G, bx, D / 64};
            pg8::EpiMerge E{(const unsigned char*)GATES, MERGED};
            pg8::gemm_phase<pg8::EpiMerge, pg8::SchedDense, true, false>(lds, S, E, tid);
        }
        SEAM(pb + 5);
        if (IN(pb + 6)) REP(6) { PHASE_PTRS();
            pg8::SchedDense S{(const char*)MERGED, (const char*)(Wb + WO_OUT), D * 2, D * 2, T / 256, D / 256, G, bx, D / 64};
            pg8::EpiDown E{(bf16*)MIX, 1.f};
            pg8::gemm_phase<pg8::EpiDown, pg8::SchedDense, true, false>(lds, S, E, tid);
        }
        SEAM(pb + 6);
        if (IN(pb + 7)) { PHASE_PTRS();
            LAS f32x4* WeL = (LAS f32x4*)lds;
            LAS f32x4* WgL = (LAS f32x4*)(lds + RING_BYTES);
            LAS int* lcnt = (LAS int*)(lds + LDSCTL_OFF + 512);
            const float* g1 = A_->ln1_g + l * D; const float* b1 = A_->ln1_b + l * D;
            const float* wrg = A_->w_rg + (size_t)l * D * 4; const float* wre = A_->w_re + (size_t)l * D * 16;
            const bf16* MIXB = (const bf16*)MIX;
            for (int idx = tid; idx < 8192; idx += 512) { const int ln = idx & 63, c4 = (idx >> 6) & 3, je = idx >> 8; const int k = 4 * ln + 256 * (je >> 2) + (je & 3);
                WeL[idx] = *(const f32x4*)(wre + (size_t)k * 16 + c4 * 4); }
            for (int idx = tid; idx < 31 * 64; idx += 512) { const int ln = idx & 63, je = idx >> 6; const int k = 4 * ln + 256 * (je >> 2) + (je & 3);
                WgL[idx] = *(const f32x4*)(wrg + (size_t)k * 4); }
            const f32x4 wg31 = *(const f32x4*)(wrg + (size_t)(4 * lane + 256 * 7 + 3) * 4);
            f32x4 gR[8], bR[8];
#pragma unroll
            for (int j = 0; j < 8; ++j) { gR[j] = *((const f32x4*)g1 + lane + 64 * j); bR[j] = *((const f32x4*)b1 + lane + 64 * j); }
            if (tid < 16) lcnt[tid] = 0;
            LDS_WAIT(); __syncthreads();
            for (int tb = bx * 128; tb < T; tb += G * 128) {
              f32x4 hn[8]; u32x2 mn[8];
              auto fetch = [&](int t) { const f32x4* hp = (const f32x4*)(hin + (size_t)t * D) + lane; const u32x2* mp = (const u32x2*)(MIXB + (size_t)t * D) + lane;
#pragma unroll
                for (int j = 0; j < 8; ++j) { hn[j] = __builtin_nontemporal_load(hp + 64 * j); mn[j] = __builtin_nontemporal_load(mp + 64 * j); } };
              fetch(tb + wave * 16);
              auto do_row = [&](const int r) { const int t = tb + wave * 16 + r;
                f32x4 v[8]; float sm = 0.f;
#pragma unroll
                for (int j = 0; j < 8; ++j) { const u32x2 mm = mn[j]; v[j] = hn[j] * DN_ALPHA + (f32x4){bflo(mm.x), bfhi(mm.x), bflo(mm.y), bfhi(mm.y)}; sm += (v[j][0] + v[j][1]) + (v[j][2] + v[j][3]); }
                fetch(r < 15 ? t + 1 : t);
                const float mean = wave_sum(sm) * (1.f / D); float s2 = 0.f;
#pragma unroll
                for (int j = 0; j < 8; ++j) { v[j] = v[j] - mean; s2 += (v[j][0] * v[j][0] + v[j][1] * v[j][1]) + (v[j][2] * v[j][2] + v[j][3] * v[j][3]); }
                const float rstd = 1.f / sqrtf(wave_sum(s2) * (1.f / D) + LN_EPS);
                f32x4* op = (f32x4*)(A_->out + (size_t)t * D) + lane; unsigned* o8 = (unsigned*)(HB8 + (size_t)t * D) + lane;
                float pe[16], pg[4];
#pragma unroll
                for (int c = 0; c < 16; ++c) pe[c] = 0.f;
#pragma unroll
                for (int c = 0; c < 4; ++c) pg[c] = 0.f;
#pragma unroll
                for (int j = 0; j < 8; ++j) {
                    const f32x4 y = v[j] * rstd * gR[j] + bR[j]; op[64 * j] = y;
                    int t0 = 0; t0 = __builtin_amdgcn_cvt_pk_fp8_f32(y[0], y[1], t0, false); t0 = __builtin_amdgcn_cvt_pk_fp8_f32(y[2], y[3], t0, true); o8[64 * j] = (unsigned)t0;
#pragma unroll
                    for (int e = 0; e < 4; ++e) { const float x = y[e];
#pragma unroll
                        for (int c4 = 0; c4 < 4; ++c4) { const f32x4 w = WeL[((j * 4 + e) * 4 + c4) * 64 + lane]; pe[4 * c4] += x * w[0]; pe[4 * c4 + 1] += x * w[1]; pe[4 * c4 + 2] += x * w[2]; pe[4 * c4 + 3] += x * w[3]; }
                        const f32x4 wg = (j * 4 + e < 31) ? WgL[(j * 4 + e) * 64 + lane] : wg31; pg[0] += x * wg[0]; pg[1] += x * wg[1]; pg[2] += x * wg[2]; pg[3] += x * wg[3]; } }
#pragma unroll
                for (int i = 0; i < 8; ++i) { const bool hi = lane & 32; const float snd = hi ? pe[i] : pe[i + 8], keep = hi ? pe[i + 8] : pe[i]; pe[i] = keep + __shfl_xor(snd, 32); }
#pragma unroll
                for (int i = 0; i < 4; ++i) { const bool hi = lane & 16; const float snd = hi ? pe[i] : pe[i + 4], keep = hi ? pe[i + 4] : pe[i]; pe[i] = keep + __shfl_xor(snd, 16); }
#pragma unroll
                for (int i = 0; i < 2; ++i) { const bool hi = lane & 8; const float snd = hi ? pe[i] : pe[i + 2], keep = hi ? pe[i + 2] : pe[i]; pe[i] = keep + __shfl_xor(snd, 8); }
                { const bool hi = lane & 4; const float snd = hi ? pe[0] : pe[1], keep = hi ? pe[1] : pe[0]; pe[0] = keep + __shfl_xor(snd, 4); }
                pe[0] += dpp_f(pe[0], 0x4E); pe[0] += dpp_f(pe[0], 0xB1);
#pragma unroll
                for (int i = 0; i < 2; ++i) { const bool hi = lane & 32; const float snd = hi ? pg[i] : pg[i + 2], keep = hi ? pg[i + 2] : pg[i]; pg[i] = keep + __shfl_xor(snd, 32); }
                { const bool hi = lane & 16; const float snd = hi ? pg[0] : pg[1], keep = hi ? pg[1] : pg[0]; pg[0] = keep + __shfl_xor(snd, 16); }
                pg[0] += dpp_f(pg[0], 0xB1); pg[0] += dpp_f(pg[0], 0x4E); pg[0] += dpp_f(pg[0], 0x141); pg[0] += dpp_f(pg[0], 0x140);
                float a[20];
#pragma unroll
                for (int c = 0; c < 4; ++c) a[c] = __builtin_bit_cast(float, __builtin_amdgcn_readlane(__builtin_bit_cast(int, pg[0]), 16 * c));
#pragma unroll
                for (int c = 0; c < 16; ++c) a[4 + c] = __builtin_bit_cast(float, __builtin_amdgcn_readlane(__builtin_bit_cast(int, pe[0]), 4 * c));
                {
                    int gs = 0; float gm = a[0];
#pragma unroll
                    for (int c = 1; c < 4; ++c) if (a[c] > gm) { gm = a[c]; gs = c; }
                    float den = 0.f;
#pragma unroll
                    for (int c = 0; c < 4; ++c) den += expf(a[c] - gm);
                    const float gval = 1.f / den;
                    float el[4];
#pragma unroll
                    for (int c = 0; c < 4; ++c) el[c] = (gs == 0) ? a[4 + c] : (gs == 1) ? a[8 + c] : (gs == 2) ? a[12 + c] : a[16 + c];
                    int e0 = 0; float v0 = el[0];
#pragma unroll
                    for (int c = 1; c < 4; ++c) if (el[c] > v0) { v0 = el[c]; e0 = c; }
                    int e1 = (e0 == 0) ? 1 : 0; float v1 = el[e1];
#pragma unroll
                    for (int c = 0; c < 4; ++c) if (c != e0 && el[c] > v1) { v1 = el[c]; e1 = c; }
                    const float p1 = expf(v1 - v0), w0 = gval / (1.f + p1), w1 = gval * p1 / (1.f + p1);
                    const int ge0 = gs * 4 + e0, ge1 = gs * 4 + e1;
                    if (lane == 0) { *(int2*)(route_e + (size_t)t * 2) = make_int2(ge0, ge1); *(f32x2*)(route_w + (size_t)t * 2) = (f32x2){w0, w1};
                        atomicAdd((int*)(lcnt + ge0), 1); atomicAdd((int*)(lcnt + ge1), 1); }
                }
              };
              do_row(0);
              for (int r = 1; r < 16; ++r) do_row(r);
            }
            LDS_WAIT(); __syncthreads();
            { unsigned z1_ = 0u; asm volatile("" : "+v"(z1_)); const int tid2 = wave0_ * 64 + (int)__builtin_amdgcn_mbcnt_hi(~0u, __builtin_amdgcn_mbcnt_lo(~0u, z1_));
              if (tid2 < 16) cnt_wg[bx * 16 + tid2] = lcnt[tid2]; }
        }
        SEAM(pb + 7);
        if (IN(pb + 9)) REP(9) { PHASE_PTRS();
            LAS int* tab = (LAS int*)(lds + 0);
            LAS int* part = (LAS int*)(lds + 16384);
            LAS int* tot = (LAS int*)(lds + 16384 + 2048);
            LAS int* eoff = (LAS int*)(lds + 16384 + 2048 + 64);
            LAS int* mybase = (LAS int*)(lds + 16384 + 2048 + 192);
            LAS int* cur = (LAS int*)(lds + 16384 + 2048 + 256);
            for (int i = tid; i < G * 16; i += 512) tab[i] = cnt_wg[i];
            LDS_WAIT(); __syncthreads();
            { const int e = tid & 15, ch = tid >> 4; int sacc = 0; for (int j = 0; j < 8; ++j) { const int wgi = ch * 8 + j; if (wgi < G) sacc += tab[wgi * 16 + e]; } part[ch * 16 + e] = sacc; }
            LDS_WAIT(); __syncthreads();
            if (tid < 16) { int sall = 0, sbefore = 0; const int mych = bx >> 3;
                for (int ch = 0; ch < 32; ++ch) { const int v = part[ch * 16 + tid]; sall += v; if (ch < mych) sbefore += v; }
                for (int wgi = mych * 8; wgi < bx; ++wgi) sbefore += tab[wgi * 16 + tid];
                tot[tid] = sall; mybase[tid] = sbefore; cur[tid] = 0; }
            LDS_WAIT(); __syncthreads();
            if (tid == 0) { int o = 0; for (int e = 0; e < 16; ++e) { eoff[e] = o; o += (tot[e] + 255) & ~255; } eoff[16] = o; }
            LDS_WAIT(); __syncthreads();
            if (bx == 0 && tid <= 16) tile_off_g[tid] = eoff[tid] >> 8;
            for (int tb = bx * 128; tb < T; tb += G * 128) {
                LAS int* wcnt = part;
                int e = -1; const int t = tb + (tid >> 1), k = tid & 1;
                if (tid < 256) e = route_e[t * 2 + k];
                int rank_in_wave = 0;
                if (tid < 256) {
#pragma unroll
                    for (int x = 0; x < 16; ++x) { const unsigned long long m = __ballot(e == x); if (e == x) rank_in_wave = __popcll(m & ((1ull << lane) - 1ull)); if (lane == 0) wcnt[wave * 16 + x] = __popcll(m); }
                }
                LDS_WAIT(); __syncthreads();
                if (tid < 256) { int before = 0; for (int wv = 0; wv < wave; ++wv) before += wcnt[wv * 16 + e];
                    const int p = eoff[e] + mybase[e] + before + rank_in_wave;
                    row_tok[p] = t; row_dst[t * 2 + k] = p; }
                (void)cur;
            }
            if (bx < 16) { const int e = bx; const int beg = eoff[e] + tot[e], end = eoff[e + 1]; for (int p = beg + tid; p < end; p += 512) { row_tok[p] = 0; } }
        }
        SEAM(pb + 9);
        if (IN(pb + 10)) REP(10) { PHASE_PTRS();
            LAS int* toff = (LAS int*)(lds + MISC_OFF + 64);
            if (tid <= 16) toff[tid] = tile_off_g[tid];
            LDS_WAIT(); __syncthreads();
            pg8::SchedMoe S{(const char*)HB8, (const char*)(W8 + W8_GU), D, D, (size_t)2048 * D, 8, G, bx, D / 128, toff, row_tok, true};
            pg8::EpiSwiglu E{HID8, W8_INV};
            pg8::gemm_phase<pg8::EpiSwiglu, pg8::SchedMoe, true, true, true>(lds, S, E, tid);
        }
        SEAM(pb + 10);
        if (IN(pb + 11)) REP(11) { PHASE_PTRS();
            LAS int* toff = (LAS int*)(lds + MISC_OFF + 64);
            if (tid <= 16) toff[tid] = tile_off_g[tid];
            LDS_WAIT(); __syncthreads();
            pg8::SchedMoe S{(const char*)HID8, (const char*)(W8 + W8_DN), DEXP, DEXP, (size_t)D * DEXP, 8, G, bx, DEXP / 128, toff, nullptr, true};
            pg8::EpiDown E{YB, W8_INV * HID8_INV};
            pg8::gemm_phase<pg8::EpiDown, pg8::SchedMoe, true, false, true>(lds, S, E, tid);
        }
        SEAM(pb + 11);
        if (IN(pb + 12)) { PHASE_PTRS();
            const float* g2 = A_->ln2_g + l * D; const float* b2 = A_->ln2_b + l * D;
            LAS f32x4* gbL = (LAS f32x4*)lds;
            for (int i = tid; i < 1024; i += 512) gbL[i] = (i < 512) ? *((const f32x4*)g2 + i) : *((const f32x4*)b2 + (i - 512));
            LDS_WAIT(); __syncthreads();
            f32x4 hA[8], hB[8]; u32x4 yaA[4], ycA[4], yaB[4], ycB[4]; float w0A = 0.f, w1A = 0.f, w0B = 0.f, w1B = 0.f;
            int s0i = 0, s1i = 0; float w0i = 0.f, w1i = 0.f;
            typedef const __attribute__((address_space(4))) int c4i; typedef const __attribute__((address_space(4))) float c4f;
            c4i* rd4 = (c4i*)row_dst; c4f* rw4 = (c4f*)route_w;
            auto load_idx = [&](int t) { s0i = rd4[t * 2]; s1i = rd4[t * 2 + 1]; w0i = rw4[t * 2]; w1i = rw4[t * 2 + 1]; };
#define LN2_FETCH(H_, YA_, YC_, W0_, W1_, t_) do { const f32x4* hp = (const f32x4*)(A_->out + (size_t)(t_) * D) + 2 * lane; W0_ = w0i; W1_ = w1i; \
                const u32x4* y0 = (const u32x4*)(YB + (size_t)s0i * D) + lane; const u32x4* y1 = (const u32x4*)(YB + (size_t)s1i * D) + lane; \
                _Pragma("unroll") for (int jj = 0; jj < 4; ++jj) { H_[2 * jj] = __builtin_nontemporal_load(hp + 128 * jj); H_[2 * jj + 1] = __builtin_nontemporal_load(hp + 128 * jj + 1); \
                    YA_[jj] = __builtin_nontemporal_load(y0 + 64 * jj); YC_[jj] = __builtin_nontemporal_load(y1 + 64 * jj); } } while (0)
#define LN2_ROW(H_, YA_, YC_, W0_, W1_, t_, WR8_) do { const int tr_ = (t_); \
                f32x4 v[8]; float sm = 0.f; const float w0 = W0_, w1 = W1_; \
                _Pragma("unroll") for (int jj = 0; jj < 4; ++jj) { u32x4 a = YA_[jj], c = YC_[jj]; asm volatile("" : "+v"(a), "+v"(c));        \
                    const f32x4 ya0 = (f32x4){bflo(a.x), bfhi(a.x), bflo(a.y), bfhi(a.y)}, yc0 = (f32x4){bflo(c.x), bfhi(c.x), bflo(c.y), bfhi(c.y)}; \
                    const f32x4 ya1 = (f32x4){bflo(a.z), bfhi(a.z), bflo(a.w), bfhi(a.w)}, yc1 = (f32x4){bflo(c.z), bfhi(c.z), bflo(c.w), bfhi(c.w)}; \
                    v[2 * jj] = H_[2 * jj] * DN_ALPHA + (ya0 * w0 + yc0 * w1); v[2 * jj + 1] = H_[2 * jj + 1] * DN_ALPHA + (ya1 * w0 + yc1 * w1); \
                    sm += ((v[2 * jj][0] + v[2 * jj][1]) + (v[2 * jj][2] + v[2 * jj][3])) + ((v[2 * jj + 1][0] + v[2 * jj + 1][1]) + (v[2 * jj + 1][2] + v[2 * jj + 1][3])); } \
                { const int tn = tr_ + 2 * NGW < T ? tr_ + 2 * NGW : tr_; LN2_FETCH(H_, YA_, YC_, W0_, W1_, tn); load_idx(tr_ + 3 * NGW < T ? tr_ + 3 * NGW : tr_); } \
                const float mean = wave_sum(sm) * (1.f / D); float s2 = 0.f; \
                _Pragma("unroll") for (int j = 0; j < 8; ++j) { v[j] = v[j] - mean; s2 += (v[j][0] * v[j][0] + v[j][1] * v[j][1]) + (v[j][2] * v[j][2] + v[j][3] * v[j][3]); } \
                const float rstd = 1.f / sqrtf(wave_sum(s2) * (1.f / D) + LN_EPS); \
                f32x4* op = (f32x4*)(A_->out + (size_t)tr_ * D) + 2 * lane; u32x2* o8 = (u32x2*)(HB8 + (size_t)tr_ * D) + lane; \
                unsigned gbo_ = (unsigned)lane * 32u; asm volatile("" : "+v"(gbo_));        \
                _Pragma("unroll") for (int jj = 0; jj < 4; ++jj) { \
                    const f32x4 g0 = *(const LAS f32x4*)(lds + gbo_ + 2048 * jj), b0 = *(const LAS f32x4*)(lds + gbo_ + 8192 + 2048 * jj); \
                    const f32x4 g1 = *(const LAS f32x4*)(lds + gbo_ + 2048 * jj + 16), b1 = *(const LAS f32x4*)(lds + gbo_ + 8192 + 2048 * jj + 16); \
                    const f32x4 y0v = v[2 * jj] * rstd * g0 + b0, y1v = v[2 * jj + 1] * rstd * g1 + b1; op[128 * jj] = y0v; op[128 * jj + 1] = y1v; \
                    if (WR8_) { int t0 = 0, t1 = 0; t0 = __builtin_amdgcn_cvt_pk_fp8_f32(y0v[0], y0v[1], t0, false); t0 = __builtin_amdgcn_cvt_pk_fp8_f32(y0v[2], y0v[3], t0, true); \
                        t1 = __builtin_amdgcn_cvt_pk_fp8_f32(y1v[0], y1v[1], t1, false); t1 = __builtin_amdgcn_cvt_pk_fp8_f32(y1v[2], y1v[3], t1, true); o8[64 * jj] = (u32x2){(unsigned)t0, (unsigned)t1}; } } } while (0)
#define LN2_ALL(WR8_) do { \
            { const int r0 = gw, r1 = r0 + NGW, r2 = r0 + 2 * NGW < T ? r0 + 2 * NGW : r0; \
              load_idx(r0); LN2_FETCH(hA, yaA, ycA, w0A, w1A, r0); load_idx(r1); LN2_FETCH(hB, yaB, ycB, w0B, w1B, r1); load_idx(r2); } \
            { LN2_ROW(hA, yaA, ycA, w0A, w1A, gw, WR8_); LN2_ROW(hB, yaB, ycB, w0B, w1B, gw + NGW, WR8_); } \
            for (int t = gw + 2 * NGW; t + NGW < T; t += 2 * NGW) { LN2_ROW(hA, yaA, ycA, w0A, w1A, t, WR8_); LN2_ROW(hB, yaB, ycB, w0B, w1B, t + NGW, WR8_); } } while (0)
            if (l + 1 < DEPTH) LN2_ALL(true); else LN2_ALL(false);
#undef LN2_ALL
#undef LN2_FETCH
#undef LN2_ROW
        }
        if (l + 1 == DEPTH) SEAM(pb + 12); else __syncthreads();
    }
#ifdef DBG_DUMP
    if (lo == 999) { const int l = 0; PHASE_PTRS();
        const bf16* src = (const bf16*)(ws + DBG_DUMP_OFF);
        for (size_t i = (size_t)bx * 512 + tid; i < (size_t)T * D; i += (size_t)G * 512) { const size_t t = i / D, c = i % D; const unsigned w = src[t * DBG_DUMP_PITCH + DBG_DUMP_COL + c]; A_->out[i] = bflo(w); }
    }
#endif
#undef IN
#undef SEAM
}

extern "C" void kernel_launch(void* const* d_in, const int* in_sizes, int n_in, void* d_out, int out_size, void* d_ws, size_t ws_size, hipStream_t stream) {
    static int grid = 0;
    if (grid == 0) {
        if (n_in != 19 || in_sizes[0] != T * D || out_size != T * D || ws_size < WS_END) { fprintf(stderr, "kernel_launch: unexpected shapes / workspace (n_in %d, ws %zu); nothing launched\n", n_in, ws_size); grid = -1; return; }
        int dev = 0, cus = 0, per_cu = 0;
        if (hipGetDevice(&dev) != hipSuccess || hipDeviceGetAttribute(&cus, hipDeviceAttributeMultiprocessorCount, dev) != hipSuccess) { grid = -1; return; }
        if (hipFuncSetAttribute((const void*)mega_fwd, hipFuncAttributeMaxDynamicSharedMemorySize, LDS_BYTES) != hipSuccess) { fprintf(stderr, "kernel_launch: hipFuncSetAttribute failed\n"); grid = -1; return; }
        if (hipOccupancyMaxActiveBlocksPerMultiprocessor(&per_cu, (const void*)mega_fwd, 512, LDS_BYTES) != hipSuccess || per_cu < 1) fprintf(stderr, "kernel_launch: occupancy query says %d\n", per_cu);
        (void)hipGetLastError();
        grid = cus;
    }
    if (grid < 0) return;
    (void)hipMemsetAsync((char*)d_ws + WS_CTL, 0, CTL_ZERO_BYTES, stream);
    Args a{};
    a.x = (const float*)d_in[0]; a.pos = (const int*)d_in[1]; a.w_in = (const float*)d_in[2]; a.w_gate = (const float*)d_in[3]; a.b_gate = (const float*)d_in[4];
    a.w_br_a = (const float*)d_in[5]; a.w_br_b = (const float*)d_in[6]; a.w_br_c = (const float*)d_in[7]; a.w_out = (const float*)d_in[8]; a.sinks = (const float*)d_in[9];
    a.ln1_g = (const float*)d_in[10]; a.ln1_b = (const float*)d_in[11]; a.w_rg = (const float*)d_in[12]; a.w_re = (const float*)d_in[13];
    a.w_eg = (const float*)d_in[14]; a.w_eu = (const float*)d_in[15]; a.w_ed = (const float*)d_in[16]; a.ln2_g = (const float*)d_in[17]; a.ln2_b = (const float*)d_in[18];
    a.out = (float*)d_out; a.ws = (unsigned char*)d_ws; a.pad = 0;
#if MK_ONE_LAUNCH
    a.ph_lo = 0; a.ph_hi = DEPTH * NPH; a.li = 0;
    hipLaunchKernelGGL(mega_fwd, dim3(grid), dim3(512), LDS_BYTES, stream, a);
#else
#ifndef DBG_NPHASES
#define DBG_NPHASES (DEPTH * NPH)
#endif
    for (int p = 0; p < DBG_NPHASES; ++p) { a.ph_lo = p; a.ph_hi = p + 1; a.li = 0; hipLaunchKernelGGL(mega_fwd, dim3(grid), dim3(512), LDS_BYTES, stream, a); }
#ifdef DBG_DUMP
    a.ph_lo = 999; a.ph_hi = 1000; hipLaunchKernelGGL(mega_fwd, dim3(grid), dim3(512), LDS_BYTES, stream, a);
#endif
#endif
}
```

```cpp
#include <hip/hip_runtime.h>
#include <cstdio>
#include <cstdint>

#ifndef DBL_MASK
#define DBL_MASK 0
#endif
#define REP(k) for (int rep_ = 0; rep_ < (((DBL_MASK >> (k)) & 1) ? 2 : 1); ++rep_)
#ifndef ATT_NAIVE_MASK
#define ATT_NAIVE_MASK 0
#endif
#ifndef MK_ONE_LAUNCH
#define MK_ONE_LAUNCH 1
#endif

#define LAS __attribute__((address_space(3)))
#define GAS __attribute__((address_space(1)))
typedef unsigned short bf16;
typedef short bf16x8 __attribute__((ext_vector_type(8)));
typedef float f32x4 __attribute__((ext_vector_type(4)));
typedef float f32x2 __attribute__((ext_vector_type(2)));
typedef unsigned u32x4 __attribute__((ext_vector_type(4)));
typedef unsigned u32x2 __attribute__((ext_vector_type(2)));

constexpr int D = 2048, NBATCH = 8, SEQ = 4096, T = NBATCH * SEQ, DEPTH = 2, HD = 128;
constexpr int NQH = 20, NKVH = 14, NPROJ = (NQH + 2 * NKVH) * HD;
constexpr int KOFF = NQH * HD, VOFF = (NQH + NKVH) * HD;
constexpr int NEXP = 16, DEXP = 1024;
constexpr int MAXSLOT = 2 * T + NEXP * 256;
constexpr float LN_EPS = 1e-5f;
constexpr float DN_ALPHA = 1.4142135623730951f;
constexpr float QSCALE = 0.08838834764831845f * 1.4426950408889634f;
constexpr float LN2F = 0.6931471805599453f;
constexpr int NPH = 13;

constexpr size_t MiB = 1u << 20;
constexpr size_t WS_CTL = 0, CTL_ZERO_BYTES = 1 * MiB;
constexpr size_t WS_ROUTE_E = 1 * MiB;
constexpr size_t WS_ROUTE_W = WS_ROUTE_E + (size_t)T * 8;
constexpr size_t WS_ROWTOK = WS_ROUTE_W + (size_t)T * 8;
constexpr size_t WS_ROWDST = WS_ROWTOK + (size_t)MAXSLOT * 4;
constexpr size_t WS_ROWW = WS_ROWDST + (size_t)MAXSLOT * 4;
constexpr size_t WS_CNTWG = WS_ROWW + (size_t)MAXSLOT * 4;
constexpr size_t WS_TILEOFF = WS_CNTWG + 256 * 16 * 4;
constexpr size_t WS_KMEAN = WS_TILEOFF + 256;
constexpr size_t WS_MISC_END = WS_KMEAN + (size_t)NBATCH * 16 * 6 * 128 * 4 * 4;
static_assert(WS_MISC_END <= 8 * MiB, "misc region");
constexpr size_t WS_ROPE = 8 * MiB;
constexpr size_t WS_SCR = 24 * MiB;
constexpr size_t WS_W = 88 * MiB;
constexpr size_t WS_HB = 344 * MiB;
constexpr size_t WS_R1 = 472 * MiB;
constexpr size_t WS_R2 = 856 * MiB;
constexpr size_t WS_R3 = 984 * MiB;
constexpr size_t WS_HB8 = 1112 * MiB;
constexpr size_t WS_END = 1176 * MiB;
constexpr size_t WO_IN = 0, WO_GATE = WO_IN + (size_t)NPROJ * D, WO_BR = WO_GATE + (size_t)NPROJ * D, WO_OUT = WO_BR + (size_t)D * D,
                 WO_GU = WO_OUT + (size_t)D * D, WO_DN = WO_GU + (size_t)NEXP * 2048 * D, WO_END = WO_DN + (size_t)NEXP * D * DEXP;
static_assert(WO_END * 2 == 256 * MiB, "weights region");
constexpr size_t W8_IN = WO_IN * 2, W8_GATE = WO_GATE * 2, W8_GU = WO_GU * 2, W8_DN = WO_DN * 2;
constexpr float W8_SCALE = 64.f, W8_INV = 1.f / 64.f, HID8_INV = 1.f / 8.f;
constexpr int CW_BAR = 4096;

constexpr int RING_BYTES = 131072;
constexpr int LDS_BYTES = 163840;
constexpr int LDSCTL_OFF = LDS_BYTES - 1024, MISC_OFF = LDSCTL_OFF + 320;

#define LDS_WAIT() asm volatile("s_waitcnt lgkmcnt(0)" ::: "memory")
#define VM_WAIT() asm volatile("s_waitcnt vmcnt(0)" ::: "memory")
__device__ __forceinline__ unsigned f2bf(float f) { unsigned u = __builtin_bit_cast(unsigned, f); return (u + 0x7fffu + ((u >> 16) & 1u)) >> 16; }
__device__ __forceinline__ unsigned pk2(float lo, float hi) { return f2bf(lo) | (f2bf(hi) << 16); }
__device__ __forceinline__ float bflo(unsigned w) { return __builtin_bit_cast(float, w << 16); }
__device__ __forceinline__ float bfhi(unsigned w) { return __builtin_bit_cast(float, w & 0xffff0000u); }
typedef __bf16 bf16x2_t __attribute__((ext_vector_type(2)));
__device__ __forceinline__ unsigned cvt_pk_bf16(float lo, float hi) { f32x2 v = {lo, hi}; bf16x2_t b = __builtin_convertvector(v, bf16x2_t); return __builtin_bit_cast(unsigned, b); }

namespace pg8 {
constexpr int BM = 256, BK = 64, HALF = 128, HTB = HALF * BK * 2, STAGE_BYTES = 8 * HTB, NXCD = 8, WGM = 8;
__host__ __device__ __forceinline__ int lds_byte(int r, int c) { const int st = (r >> 4) * 2 + (c >> 5), rr = r & 15, cc = c & 31, ob = rr * 64 + cc * 2; return st * 1024 + (ob ^ (((ob >> 9) & 1) << 5)); }
__host__ __device__ __forceinline__ void stage_rc(int b, int& R, int& C) { const int st = b / 1024, sb = b % 1024, swz = sb ^ (((sb >> 9) & 1) << 5); R = (st >> 1) * 16 + swz / 64; C = (st & 1) * 32 + (swz % 64) / 2; }
__host__ __device__ __forceinline__ int perm32(int rho) { const int n = rho >> 4, i = rho & 15; return 8 * (i >> 2) + 4 * n + (i & 3); }

struct Unit { int pm, pn, z; };
#define GPC0(T_, base, off) ((const T_*)((const char*)(base) + (unsigned)(off)))
__device__ __forceinline__ void xcd_order(int L, int nM, int nN, int& pm, int& pn) {
    const int nwg = nM * nN; int wgid = L; { const int q = nwg / NXCD, r = nwg % NXCD, xcd = wgid % NXCD, off = wgid / NXCD; wgid = (xcd < r ? xcd * (q + 1) : r * (q + 1) + (xcd - r) * q) + off; }
    const int nig = WGM * nN, gid = wgid / nig, fm = gid * WGM, gsz = (nM - fm) < WGM ? (nM - fm) : WGM;
    pm = fm + ((wgid % nig) % gsz); pn = (wgid % nig) / gsz;
}

__host__ __device__ __forceinline__ int f8swz(int r) { return ((r >> 1) & 1) + 6 * (r >> 3); }
template <bool F8> __device__ __forceinline__ void stage_map(int b, int& R, int& CB) {
    if constexpr (F8) { R = b >> 7; CB = 16 * (((b >> 4) & 7) ^ f8swz(R & 15)); }
    else { int C; stage_rc(b, R, C); CB = C * 2; }
}
typedef int v4i __attribute__((ext_vector_type(4)));
typedef int v8i __attribute__((ext_vector_type(8)));
template <class Epi, class Sched, bool ALIGN_EPI, bool GATHER, bool F8 = false>
__device__ __forceinline__ void gemm_phase(LAS unsigned char* lds, const Sched& S, const Epi& E, const int tid) {
    const int wid = __builtin_amdgcn_readfirstlane(tid >> 6), lane = tid & 63, wr = wid >> 2, wc = wid & 3, fr = lane & 15, fq = lane >> 4;
    const unsigned lda = S.lda, ldb = S.ldb;
    unsigned voffB, voA[2][2], vnA[2][2];
    { int R, CB; stage_map<F8>(tid * 16, R, CB); const int Rb = Epi::PERM ? ((R & ~31) + perm32(R & 31)) : R;
      voffB = (unsigned)Rb * ldb + (unsigned)CB;
      voA[0][0] = (unsigned)R * lda + (unsigned)CB; voA[0][1] = voA[0][0]; voA[1][0] = voA[0][0]; voA[1][1] = voA[0][0];
      vnA[0][0] = voA[0][0]; vnA[0][1] = voA[0][0]; vnA[1][0] = voA[0][0]; vnA[1][1] = voA[0][0]; }
    const unsigned qstepA = 64u * lda, qstepB = 64u * ldb;
    const auto rsA = __builtin_amdgcn_make_buffer_rsrc((void*)S.A, 0, 0xffffffff, 0x00020000);
    const auto rsB = __builtin_amdgcn_make_buffer_rsrc((void*)S.Bt, 0, 0xffffffff, 0x00020000);
    const unsigned kstep = (unsigned)(BK * 2);
    const unsigned hstepB = (unsigned)HALF * ldb, hstepA = (unsigned)HALF * lda;
    const unsigned ldsw = (unsigned)wid * 1024u;
    const int aoff = F8 ? ((wr * 64 + fr) * 128 + 16 * ((2 * fq) ^ f8swz(fr))) : lds_byte(wr * 64 + fr, fq * 8);
    const int boff = F8 ? ((wc * 32 + fr) * 128 + 16 * ((2 * fq) ^ f8swz(fr))) : lds_byte(wc * 32 + fr, fq * 8);
#define PG8_OFF1(o) (F8 ? ({ int _o = (o); asm volatile("" : "+v"(_o)); _o ^ 16; }) : ((o) + 1024))
#define PG8_SA(b, h) (((b) * 2 + (h)) * HTB)
#define PG8_SB(b, h) ((4 + (b) * 2 + (h)) * HTB)
#define PG8_DMA(bufoff, i_, rs, vo, so) __builtin_amdgcn_raw_ptr_buffer_load_lds(rs, (LAS void*)(lds + (bufoff) + ldsw + (i_) * 8192), 16, (int)(vo), (int)(so), 0, 0)
#define PG8_STAGE_B(b, h, kb) do { PG8_DMA(PG8_SB(b, h), 0, rsB, voffB, (kb) + (h) * hstepB); PG8_DMA(PG8_SB(b, h), 1, rsB, voffB, (kb) + (h) * hstepB + qstepB); } while (0)
#define PG8_STAGE_A(b, h, ka, VO) do { if constexpr (GATHER) { PG8_DMA(PG8_SA(b, h), 0, rsA, (VO)[h][0], (ka)); PG8_DMA(PG8_SA(b, h), 1, rsA, (VO)[h][1], (ka)); } \
        else { PG8_DMA(PG8_SA(b, h), 0, rsA, (VO)[0][0], (ka) + (h) * hstepA); PG8_DMA(PG8_SA(b, h), 1, rsA, (VO)[0][0], (ka) + (h) * hstepA + qstepA); } } while (0)
#define PG8_LDA(dst, b, h) do { const int _a1 = PG8_OFF1(aoff); _Pragma("unroll") for (int m = 0; m < 4; ++m) { dst[m][0] = *(const LAS bf16x8*)(lds + PG8_SA(b, h) + aoff + m * 2048); dst[m][1] = *(const LAS bf16x8*)(lds + PG8_SA(b, h) + _a1 + m * 2048); } } while (0)
#define PG8_LDB(dst, b, h) do { const int _b1 = PG8_OFF1(boff); _Pragma("unroll") for (int n = 0; n < 2; ++n) { dst[n][0] = *(const LAS bf16x8*)(lds + PG8_SB(b, h) + boff + n * 2048); dst[n][1] = *(const LAS bf16x8*)(lds + PG8_SB(b, h) + _b1 + n * 2048); } } while (0)
#define PG8_CAT(x) __builtin_shufflevector(__builtin_bit_cast(v4i, (x)[0]), __builtin_bit_cast(v4i, (x)[1]), 0, 1, 2, 3, 4, 5, 6, 7)
#define PG8_MMA(ai, bj, At, Bt) do { int f8scale = 0x7f7f7f7f; if constexpr (F8) asm volatile("" : "+v"(f8scale)); __builtin_amdgcn_s_setprio(1); _Pragma("unroll") for (int m = 0; m < 4; ++m) _Pragma("unroll") for (int n = 0; n < 2; ++n) { \
        if constexpr (F8) acc[ai][bj][m][n] = __builtin_amdgcn_mfma_scale_f32_16x16x128_f8f6f4(PG8_CAT(Bt[n]), PG8_CAT(At[m]), acc[ai][bj][m][n], 0, 0, 0, f8scale, 0, f8scale); \
        else { _Pragma("unroll") for (int k = 0; k < 2; ++k) acc[ai][bj][m][n] = __builtin_amdgcn_mfma_f32_16x16x32_bf16(Bt[n][k], At[m][k], acc[ai][bj][m][n], 0, 0, 0); } } \
        __builtin_amdgcn_s_setprio(0); } while (0)
#define PG8_WAIT_V(n) asm volatile("s_waitcnt vmcnt(" #n ")" ::: "memory")
#define PG8_WAIT_L(n) asm volatile("s_waitcnt lgkmcnt(" #n ")" ::: "memory")
#define PG8_BAR __builtin_amdgcn_s_barrier()
#define PG8_SCHED __builtin_amdgcn_sched_barrier(0)
    Unit cur, nxt; int ui = 0;
    if (!S.next(0, cur)) return;
    f32x4 acc[2][2][4][2];
#pragma unroll
    for (int a = 0; a < 2; ++a)
#pragma unroll
        for (int b = 0; b < 2; ++b)
#pragma unroll
            for (int m = 0; m < 4; ++m)
#pragma unroll
                for (int n = 0; n < 2; ++n) acc[a][b][m][n] = (f32x4){0.f, 0.f, 0.f, 0.f};
    bf16x8 At[4][2], B0[2][2], B1[2][2];
    if constexpr (GATHER) { S.rows(cur, wid * 64, voA); }
    unsigned cA = S.a_off(cur), cB = S.b_off(cur); int nt = S.nkt(cur);
    PG8_STAGE_B(0, 0, cB); PG8_STAGE_B(0, 1, cB); PG8_STAGE_A(0, 0, cA, voA); PG8_STAGE_A(0, 1, cA, voA);
    if (wr == 1) PG8_BAR;
    PG8_WAIT_V(2); PG8_BAR;
    PG8_STAGE_B(1, 0, cB + kstep); PG8_STAGE_A(1, 0, cA + kstep, voA); PG8_STAGE_B(1, 1, cB + kstep);
    PG8_WAIT_V(6); PG8_BAR;
    for (;;) {
        const bool has_next = S.next(ui + 1, nxt);
        const unsigned nA = has_next ? S.a_off(nxt) : cA, nB = has_next ? S.b_off(nxt) : cB;
        if constexpr (GATHER) { if (has_next) S.rows(nxt, wid * 64, vnA); else { vnA[0][0] = voA[0][0]; vnA[0][1] = voA[0][1]; vnA[1][0] = voA[1][0]; vnA[1][1] = voA[1][1]; } }
        for (int t = 0; t < nt; t += 2) {
            if constexpr (Epi::HOOK) { if (t == 4 || t == 16) { unsigned z_ = 0u; asm volatile("" : "+v"(z_)); const int l2 = (int)__builtin_amdgcn_mbcnt_hi(~0u, __builtin_amdgcn_mbcnt_lo(~0u, z_)); E.hook(acc, cur, t, wr, wc, l2 & 15, l2 >> 4); } }
            const bool last = (t == nt - 2);
            const unsigned a1 = cA + (unsigned)(t + 1) * kstep;
            const unsigned a2 = last ? nA : cA + (unsigned)(t + 2) * kstep, b2 = last ? nB : cB + (unsigned)(t + 2) * kstep;
            const unsigned a3 = a2 + kstep, b3 = b2 + kstep;
            __builtin_amdgcn_s_setprio(2); PG8_LDB(B0, 0, 0); PG8_LDB(B1, 0, 1); PG8_SCHED; PG8_LDA(At, 0, 0); PG8_STAGE_A(1, 1, a1, voA);
            if constexpr (GATHER) { if (last) { voA[0][0] = vnA[0][0]; voA[0][1] = vnA[0][1]; voA[1][0] = vnA[1][0]; voA[1][1] = vnA[1][1]; } }
            __builtin_amdgcn_s_setprio(0); PG8_WAIT_V(8); PG8_WAIT_L(0); PG8_BAR; PG8_MMA(0, 0, At, B0); PG8_MMA(0, 1, At, B1); PG8_BAR; PG8_SCHED;
            __builtin_amdgcn_s_setprio(2); PG8_LDA(At, 0, 1); PG8_STAGE_B(0, 0, b2); PG8_STAGE_B(0, 1, b2); PG8_STAGE_A(0, 0, a2, voA);
            __builtin_amdgcn_s_setprio(0); PG8_WAIT_V(8); PG8_WAIT_L(0); PG8_BAR; PG8_MMA(1, 0, At, B0); PG8_MMA(1, 1, At, B1); PG8_BAR; PG8_SCHED;
            __builtin_amdgcn_s_setprio(2); PG8_LDB(B0, 1, 0); PG8_LDB(B1, 1, 1); PG8_SCHED; PG8_LDA(At, 1, 0); PG8_STAGE_A(0, 1, a2, voA);
            __builtin_amdgcn_s_setprio(0); PG8_WAIT_V(8); PG8_WAIT_L(0); PG8_BAR; PG8_MMA(0, 0, At, B0); PG8_MMA(0, 1, At, B1); PG8_BAR; PG8_SCHED;
            __builtin_amdgcn_s_setprio(2); PG8_LDA(At, 1, 1); PG8_STAGE_B(1, 0, b3); PG8_STAGE_B(1, 1, b3); PG8_STAGE_A(1, 0, a3, voA);
            __builtin_amdgcn_s_setprio(0); PG8_WAIT_V(8); PG8_WAIT_L(0); PG8_BAR; PG8_MMA(1, 0, At, B0); PG8_MMA(1, 1, At, B1); PG8_BAR; PG8_SCHED;
        }
        if constexpr (ALIGN_EPI) { if (wr == 0) PG8_BAR; }
        { unsigned z_ = 0u; asm volatile("" : "+v"(z_)); const int l2 = (int)__builtin_amdgcn_mbcnt_hi(~0u, __builtin_amdgcn_mbcnt_lo(~0u, z_)); E(acc, cur, wr, wc, l2 & 15, l2 >> 4, wid * 64 + l2); }
        if (!has_next) break;
#pragma unroll
        for (int a = 0; a < 2; ++a)
#pragma unroll
            for (int b = 0; b < 2; ++b)
#pragma unroll
                for (int m = 0; m < 4; ++m)
#pragma unroll
                    for (int n = 0; n < 2; ++n) acc[a][b][m][n] = (f32x4){0.f, 0.f, 0.f, 0.f};
        cur = nxt; cA = nA; cB = nB; nt = S.nkt(cur); ++ui;
        if constexpr (ALIGN_EPI) { if (wr == 1) PG8_BAR; }
    }
    PG8_WAIT_V(0);
    if constexpr (!ALIGN_EPI) { if (wr == 0) PG8_BAR; }
    PG8_BAR;
#undef PG8_SA
#undef PG8_SB
#undef PG8_DMA
#undef PG8_STAGE_A
#undef PG8_STAGE_B
#undef PG8_LDA
#undef PG8_LDB
#undef PG8_MMA
#undef PG8_CAT
#undef PG8_OFF1
#undef PG8_WAIT_V
#undef PG8_WAIT_L
#undef PG8_BAR
#undef PG8_SCHED
}

struct SchedDense {
    const char* A; const char* Bt; unsigned lda, ldb; int nM, nN, G, c, nk;
    __device__ __forceinline__ bool next(int i, Unit& u) const { const int L = i * G + c; if (L >= nM * nN) return false; xcd_order(L, nM, nN, u.pm, u.pn); u.z = 0; return true; }
    __device__ __forceinline__ unsigned a_off(const Unit& u) const { return (unsigned)u.pm * 256u * lda; }
    __device__ __forceinline__ unsigned b_off(const Unit& u) const { return (unsigned)u.pn * 256u * ldb; }
    __device__ __forceinline__ int nkt(const Unit&) const { return nk; }
    __device__ __forceinline__ void rows(const Unit&, int, unsigned (&)[2][2]) const {}
};
struct SchedMerge {
    const char* A; const char* Bt; unsigned lda, ldb; int nM, nN, G, c;
    __device__ __forceinline__ bool next(int i, Unit& u) const { const int i3 = i / 3; const int L = i3 * G + c; if (L >= nM * nN) return false; xcd_order(L, nM, nN, u.pm, u.pn); u.z = i - 3 * i3; return true; }
    __device__ __forceinline__ int koff(int z) const { return z == 0 ? 0 : (z == 1 ? 256 : 1024); }
    __device__ __forceinline__ unsigned a_off(const Unit& u) const { return (unsigned)u.pm * 256u * lda + (unsigned)koff(u.z) * 2u; }
    __device__ __forceinline__ unsigned b_off(const Unit& u) const { return (unsigned)u.pn * 256u * ldb + (unsigned)koff(u.z) * 2u; }
    __device__ __forceinline__ int nkt(const Unit& u) const { return u.z == 0 ? 4 : (u.z == 1 ? 12 : 16); }
    __device__ __forceinline__ void rows(const Unit&, int, unsigned (&)[2][2]) const {}
};
struct SchedMoe {
    const char* A; const char* Bt; unsigned lda, ldb; size_t bexp  ; int nN, G, c, nk; const LAS int* tile_off; const int* row_tok; bool f8;
    __device__ __forceinline__ bool next(int i, Unit& u) const {
        const int ntile = __builtin_amdgcn_readfirstlane(tile_off[16]); int rt, pn;
        if (nN == 8 && (G & 31) == 0) {
            const int x = c & 7, v = c >> 3;
            rt = i * (G >> 3) + (x >> 1) * (G >> 5) + (v >> 2); pn = 4 * (x & 1) + (v & 3);
        } else { const int L = i * G + c; rt = L / nN; pn = L - rt * nN; }
        if (rt >= ntile) return false;
        u.pm = rt; u.pn = pn; int e = 0;
#pragma unroll
        for (int j = 1; j < 16; ++j) e += (rt >= tile_off[j]) ? 1 : 0;
        u.z = __builtin_amdgcn_readfirstlane(e); return true; }
    __device__ __forceinline__ unsigned a_off(const Unit& u) const { return row_tok ? 0u : (unsigned)u.pm * 256u * lda; }
    __device__ __forceinline__ unsigned b_off(const Unit& u) const { return (unsigned)u.z * (unsigned)bexp + (unsigned)u.pn * 256u * ldb; }
    __device__ __forceinline__ int nkt(const Unit&) const { return nk; }
    __device__ __forceinline__ void rows(const Unit& u, int tid, unsigned (&vo)[2][2]) const {
#pragma unroll
        for (int i = 0; i < 2; ++i) { unsigned z_ = 0u; asm volatile("" : "+v"(z_)); const int t2 = (tid & ~63) + (int)__builtin_amdgcn_mbcnt_hi(~0u, __builtin_amdgcn_mbcnt_lo(~0u, z_)); int R, CB; if (f8) stage_map<true>(t2 * 16 + i * 8192, R, CB); else stage_map<false>(t2 * 16 + i * 8192, R, CB);
#pragma unroll
            for (int h = 0; h < 2; ++h) vo[h][i] = (unsigned)(*GPC0(int, row_tok, (unsigned)(u.pm * 256 + h * HALF + R) * 4)) * lda + (unsigned)CB; }
    }
};

#define GP(T_, base, off) ((T_*)((char*)(base) + (unsigned)(off)))
#define GPC(T_, base, off) ((const T_*)((const char*)(base) + (unsigned)(off)))
struct EpiRope {
    static constexpr bool PERM = true;
    static constexpr bool HOOK = false;
    bf16* O; const float* rope; float ascale;
    __device__ __forceinline__ void operator()(const f32x4 (&acc)[2][2][4][2], const Unit& u, int wr, int wc, int fr, int fq, int tid) const {
        const int row0 = u.pm * BM + wr * 64 + fr, hh = wc >> 1, dd0 = 32 * (wc & 1) + 8 * fq, col0 = (2 * u.pn + hh) * HD + dd0;
        const bool is_rope = u.pn < 17; const float sc = ((u.pn < 10) ? QSCALE : 1.f) * ascale;
        const unsigned ooff = (unsigned)row0 * (NPROJ * 2) + (unsigned)col0 * 2, roff = (unsigned)row0 * 512 + (unsigned)dd0 * 4;
        f32x4 rr[2][2][4];
        auto ldr = [&](int b_, f32x4 (&dst)[2][4]) { const int ai = b_ >> 1, mh = b_ & 1;
#pragma unroll
            for (int mm = 0; mm < 2; ++mm) { const f32x4* rp = GPC(f32x4, rope, roff + (unsigned)(ai * HALF + (2 * mh + mm) * 16) * 512);
                dst[mm][0] = rp[0]; dst[mm][1] = rp[1]; dst[mm][2] = rp[16]; dst[mm][3] = rp[17]; } };
        ldr(0, rr[0]);
#pragma unroll
        for (int b_ = 0; b_ < 4; ++b_) { const int ai = b_ >> 1, mh = b_ & 1;
                if (b_ + 1 < 4) ldr(b_ + 1, rr[(b_ + 1) & 1]);
                asm volatile("" ::: "memory");
#pragma unroll
                for (int mm = 0; mm < 2; ++mm) { const int m = 2 * mh + mm; const unsigned rsel = (unsigned)(ai * HALF + m * 16);
                    u32x4 w1, w2;
#pragma unroll
                    for (int n = 0; n < 2; ++n) {
                        f32x4 x1 = acc[ai][0][m][n] * sc, x2 = acc[ai][1][m][n] * sc;
                        if (is_rope) { const f32x4 c = rr[b_ & 1][mm][n], sn = rr[b_ & 1][mm][2 + n];
                            const f32x4 y1 = x1 * c - x2 * sn, y2 = x2 * c + x1 * sn; x1 = y1; x2 = y2; }
                        const unsigned a0 = cvt_pk_bf16(x1[0], x1[1]), a1 = cvt_pk_bf16(x1[2], x1[3]), b0 = cvt_pk_bf16(x2[0], x2[1]), b1 = cvt_pk_bf16(x2[2], x2[3]);
                        if (n == 0) { w1.x = a0; w1.y = a1; w2.x = b0; w2.y = b1; } else { w1.z = a0; w1.w = a1; w2.z = b0; w2.w = b1; }
                    }
                    u32x4* rowp = GP(u32x4, O, ooff + rsel * (NPROJ * 2));
                    rowp[0] = w1; rowp[8] = w2; }
                asm volatile("" ::: "memory");
            }
    }
};
__device__ __forceinline__ float sigmoid_f(float x) { return __builtin_amdgcn_rcpf(1.f + __expf(-x)); }
__device__ __forceinline__ unsigned q8(float g) { return (unsigned)(g * 255.f + 0.5f); }
struct EpiGate {
    static constexpr bool PERM = true;
    static constexpr bool HOOK = false;
    unsigned char* O; const float* bias; float ascale;
    __device__ __forceinline__ void operator()(const f32x4 (&acc)[2][2][4][2], const Unit& u, int wr, int wc, int fr, int fq, int tid) const {
        const int row0 = u.pm * BM + wr * 64 + fr, col0 = u.pn * BM + wc * 32 + 8 * fq;
        const unsigned ooff = (unsigned)row0 * NPROJ + (unsigned)col0;
        f32x4 bb[2][2];
#pragma unroll
        for (int bj = 0; bj < 2; ++bj) { bb[bj][0] = *GPC(f32x4, bias, (col0 + bj * HALF) * 4); bb[bj][1] = *GPC(f32x4, bias, (col0 + bj * HALF + 4) * 4); }
#pragma unroll
        for (int bj = 0; bj < 2; ++bj) {
            const f32x4 b0 = bb[bj][0], b1 = bb[bj][1];
#pragma unroll
            for (int ai = 0; ai < 2; ++ai)
#pragma unroll
                for (int m = 0; m < 4; ++m) { const f32x4 v0 = acc[ai][bj][m][0] * ascale + b0, v1 = acc[ai][bj][m][1] * ascale + b1;
                    u32x2 w; w.x = q8(sigmoid_f(v0[0])) | (q8(sigmoid_f(v0[1])) << 8) | (q8(sigmoid_f(v0[2])) << 16) | (q8(sigmoid_f(v0[3])) << 24);
                    w.y = q8(sigmoid_f(v1[0])) | (q8(sigmoid_f(v1[1])) << 8) | (q8(sigmoid_f(v1[2])) << 16) | (q8(sigmoid_f(v1[3])) << 24);
                    *GP(u32x2, O, ooff + (unsigned)(ai * HALF + m * 16) * NPROJ + bj * HALF) = w;
                    asm volatile("" ::: "memory"); }
        }
    }
};
struct EpiMerge {
    static constexpr bool PERM = true;
    static constexpr bool HOOK = true;
    const unsigned char* Gt; bf16* O;
    static __device__ __forceinline__ void dec(unsigned w, f32x4& o) { o = (f32x4){fmaxf((float)(w & 0xffu), 1.f), fmaxf((float)((w >> 8) & 0xffu), 1.f), fmaxf((float)((w >> 16) & 0xffu), 1.f), fmaxf((float)(w >> 24), 1.f)}; }
    __device__ __forceinline__ void ldg(unsigned base, u32x2 (&g)[4][2]) const { unsigned o_ = base;
#pragma unroll
        for (int m = 0; m < 4; ++m) { asm volatile("" : "+v"(o_)); g[m][0] = *GPC(u32x2, Gt, o_); g[m][1] = *GPC(u32x2, Gt, o_ + HALF); o_ += 16u * NPROJ; } }
    __device__ __forceinline__ void hook(f32x4 (&acc)[2][2][4][2], const Unit& u, int t, int wr, int wc, int fr, int fq) const {
        const int row0 = u.pm * BM + wr * 64 + fr, col0 = u.pn * BM + wc * 32 + 8 * fq; const int br = (t == 4) ? 0 : 1;
        const unsigned goff = (unsigned)row0 * NPROJ + (unsigned)(br * D + col0);
        u32x2 g[2][4][2], h[2][4][2];
#pragma unroll
        for (int ai = 0; ai < 2; ++ai) { ldg(goff + (unsigned)(ai * HALF) * NPROJ, g[ai]); ldg(goff + (unsigned)D + (unsigned)(ai * HALF) * NPROJ, h[ai]); }
        __builtin_amdgcn_sched_barrier(0);
#pragma unroll
        for (int ai = 0; ai < 2; ++ai)
#pragma unroll
            for (int m = 0; m < 4; ++m)
#pragma unroll
                for (int bj = 0; bj < 2; ++bj) { f32x4 a0, a1, b0, b1; dec(g[ai][m][bj].x, a0); dec(g[ai][m][bj].y, a1); dec(h[ai][m][bj].x, b0); dec(h[ai][m][bj].y, b1);
#pragma unroll
                    for (int j = 0; j < 4; ++j) { a0[j] *= __builtin_amdgcn_rcpf(b0[j]); a1[j] *= __builtin_amdgcn_rcpf(b1[j]); }
                    acc[ai][bj][m][0] *= a0; acc[ai][bj][m][1] *= a1; }
    }
    __device__ __forceinline__ void operator()(const f32x4 (&acc)[2][2][4][2], const Unit& u, int wr, int wc, int fr, int fq, int tid) const {
        const int row0 = u.pm * BM + wr * 64 + fr, col0 = u.pn * BM + wc * 32 + 8 * fq;
        const unsigned goff = (unsigned)row0 * NPROJ + (unsigned)(2 * D + col0), ooff = (unsigned)row0 * (D * 2) + (unsigned)col0 * 2;
        u32x2 g[2][4][2];
#pragma unroll
        for (int ai = 0; ai < 2; ++ai) ldg(goff + (unsigned)(ai * HALF) * NPROJ, g[ai]);
        __builtin_amdgcn_sched_barrier(0);
#pragma unroll
        for (int ai = 0; ai < 2; ++ai) { unsigned oo_ = ooff + (unsigned)(ai * HALF) * (D * 2);
#pragma unroll
            for (int m = 0; m < 4; ++m) { asm volatile("" : "+v"(oo_));
#pragma unroll
                for (int bj = 0; bj < 2; ++bj) { f32x4 a0, a1; dec(g[ai][m][bj].x, a0); dec(g[ai][m][bj].y, a1); constexpr float I255 = 1.f / 255.f;
                    const f32x4 v0 = acc[ai][bj][m][0] * (a0 * I255), v1 = acc[ai][bj][m][1] * (a1 * I255);
                    u32x4 w; w.x = cvt_pk_bf16(v0[0], v0[1]); w.y = cvt_pk_bf16(v0[2], v0[3]); w.z = cvt_pk_bf16(v1[0], v1[1]); w.w = cvt_pk_bf16(v1[2], v1[3]);
                    *GP(u32x4, O, oo_ + bj * 256) = w; }
                oo_ += 16u * (D * 2); } }
    }
};
struct EpiF32 {
    static constexpr bool PERM = false;
    static constexpr bool HOOK = false;
    float* C;
    __device__ __forceinline__ void operator()(const f32x4 (&acc)[2][2][4][2], const Unit& u, int wr, int wc, int fr, int fq, int tid) const {
        const int row0 = u.pm * BM + wr * 64 + fr, col0 = u.pn * BM + wc * 32 + 4 * fq;
        const unsigned ooff = (unsigned)row0 * (D * 4) + (unsigned)col0 * 4;
#pragma unroll
        for (int ai = 0; ai < 2; ++ai)
#pragma unroll
            for (int m = 0; m < 4; ++m) { f32x4* rowp = GP(f32x4, C, ooff + (unsigned)(ai * HALF + m * 16) * (D * 4));
#pragma unroll
                for (int bj = 0; bj < 2; ++bj)
#pragma unroll
                    for (int n = 0; n < 2; ++n) rowp[bj * 32 + n * 4] = acc[ai][bj][m][n]; }
    }
};
struct EpiSwiglu {
    static constexpr bool PERM = true;
    static constexpr bool HOOK = false;
    unsigned char* Hd; float ascale;
    __device__ __forceinline__ void operator()(const f32x4 (&acc)[2][2][4][2], const Unit& u, int wr, int wc, int fr, int fq, int tid) const {
        const int row0 = u.pm * BM + wr * 64 + fr, col0 = u.pn * HALF + wc * 32 + 8 * fq;
        const unsigned ooff = (unsigned)row0 * DEXP + (unsigned)col0;
#pragma unroll
        for (int ai = 0; ai < 2; ++ai)
#pragma unroll
            for (int m = 0; m < 4; ++m) {
                float h[8];
#pragma unroll
                for (int n = 0; n < 2; ++n)
#pragma unroll
                    for (int j = 0; j < 4; ++j) { const float g = acc[ai][0][m][n][j] * ascale, up = acc[ai][1][m][n][j] * ascale; h[n * 4 + j] = g * sigmoid_f(g) * up * 8.f; }
                u32x2 w; int t0 = 0, t1 = 0;
                t0 = __builtin_amdgcn_cvt_pk_fp8_f32(h[0], h[1], t0, false); t0 = __builtin_amdgcn_cvt_pk_fp8_f32(h[2], h[3], t0, true);
                t1 = __builtin_amdgcn_cvt_pk_fp8_f32(h[4], h[5], t1, false); t1 = __builtin_amdgcn_cvt_pk_fp8_f32(h[6], h[7], t1, true);
                w.x = (unsigned)t0; w.y = (unsigned)t1;
                *GP(u32x2, Hd, ooff + (unsigned)(ai * HALF + m * 16) * DEXP) = w; }
    }
};
struct EpiDown {
    static constexpr bool PERM = true;
    static constexpr bool HOOK = false;
    bf16* Y; float ascale;
    __device__ __forceinline__ void operator()(const f32x4 (&acc)[2][2][4][2], const Unit& u, int wr, int wc, int fr, int fq, int tid) const {
        const int row0 = u.pm * BM + wr * 64 + fr, col0 = u.pn * BM + wc * 32 + 8 * fq;
        const unsigned ooff = (unsigned)row0 * (D * 2) + (unsigned)col0 * 2;
#pragma unroll
        for (int ai = 0; ai < 2; ++ai)
#pragma unroll
            for (int m = 0; m < 4; ++m) { u32x4* yp = GP(u32x4, Y, ooff + (unsigned)(ai * HALF + m * 16) * (D * 2));
#pragma unroll
                for (int bj = 0; bj < 2; ++bj) { const f32x4 v0 = acc[ai][bj][m][0] * ascale, v1 = acc[ai][bj][m][1] * ascale;
                    u32x4 w; w.x = cvt_pk_bf16(v0[0], v0[1]); w.y = cvt_pk_bf16(v0[2], v0[3]); w.z = cvt_pk_bf16(v1[0], v1[1]); w.w = cvt_pk_bf16(v1[2], v1[3]);
                    yp[bj * 16] = w; } }
    }
};
}


namespace att {
typedef float f32x16 __attribute__((ext_vector_type(16)));
typedef short s16x4 __attribute__((ext_vector_type(4)));
typedef short v4i16_t __attribute__((ext_vector_type(4)));
constexpr int KV_OFF = 0, V_OFF = 65536, KM_OFF = 114688, SLOT_OFF = 114688 + 8192;
__device__ __forceinline__ unsigned off_b(unsigned row, unsigned ch) { return 256u * row + 16u * (ch ^ (((row & 3) << 2) | ((row >> 2) & 3))); }
__device__ __forceinline__ s16x4 vtr(const LAS unsigned char* p) { return __builtin_bit_cast(s16x4, __builtin_amdgcn_ds_read_tr16_b64_v4i16((LAS v4i16_t*)p)); }

__device__ __forceinline__ float xhalf_max(float v) { return fmaxf(v, __shfl_xor(v, 32)); }
__device__ __forceinline__ float xhalf_sum(float v) { return v + __shfl_xor(v, 32); }

template <int MODE>
__device__ __forceinline__ void attn_queue(LAS unsigned char* lds, const bf16* QKV, bf16* ATT, bf16* PA, float* LSEA, const float* KMEAN, const float* sinks, unsigned* qctr, const int tid) {
    const int lane = tid & 63, wave = __builtin_amdgcn_readfirstlane(tid >> 6), r32 = lane & 31, hh = lane >> 5;
    constexpr int NITEMS = (MODE == 2) ? 1024 : 768;
    LAS int* slot = (LAS int*)(lds + SLOT_OFF);
    LAS float* km = (LAS float*)(lds + KM_OFF);
    const unsigned pi = (unsigned)((r32 & 0x13) | ((r32 & 4) << 1) | ((r32 & 8) >> 1));
    const unsigned kx = ((pi & 3) << 2) | ((pi >> 2) & 3), krow = 256u * pi;
    const unsigned vq = (unsigned)((lane & 15) >> 2), vp = (unsigned)(lane & 3), vblk = (unsigned)((lane >> 4) & 1);
    unsigned vbase[2];
#pragma unroll
    for (int t_ = 0; t_ < 2; ++t_) vbase[t_] = 256u * (unsigned)(8 * hh + 4 * t_ + (int)vq) + 16u * ((2u * vblk + (vp >> 1)) ^ (unsigned)(2 * hh + t_)) + 8u * (vp & 1);
#define vcq_(c_) (64u * ((unsigned)(c_) ^ vq))
    const unsigned kz = (unsigned)hh ^ kx;
    const auto rsrc = __builtin_amdgcn_make_buffer_rsrc((void*)QKV, 0, 0xffffffff, 0x00020000);
    unsigned drow[2], dch[2];
#pragma unroll
    for (int i = 0; i < 2; ++i) { drow[i] = (unsigned)(8 * wave + 4 * i + (lane >> 4)); dch[i] = (unsigned)(lane & 15) ^ ((((unsigned)(lane >> 4) & 3u) << 2) | ((unsigned)(2 * wave + i) & 3u)); }

    __syncthreads();
    int qcur = (MODE == 1) ? (int)(__builtin_amdgcn_s_getreg((3 << 11) | 20) & 7u) : 0, qtries = 0;
    auto fetch = [&]() -> int {
        if constexpr (MODE != 1) return (int)__hip_atomic_fetch_add(qctr, 1u, __ATOMIC_RELAXED, __HIP_MEMORY_SCOPE_AGENT);
        else { for (;;) { if (qtries >= 8) return NITEMS; const int idx = (int)__hip_atomic_fetch_add(qctr + 16 * qcur, 1u, __ATOMIC_RELAXED, __HIP_MEMORY_SCOPE_AGENT);
                          if (idx < 96) return qcur * 96 + idx; qcur = (qcur + 1) & 7; ++qtries; } } };
    if (tid == 0) slot[0] = fetch();
    LDS_WAIT(); __syncthreads();
    int item = slot[0];
    while (item < NITEMS) {
        int nxt_local = 0;
        if (tid == 0) nxt_local = fetch();
        int b, khead, ntiles, dil = 1, res = 0, m0 = 0, nblk = 0, hB = 0, grp = 0;
        int qhead;
        if constexpr (MODE == 0) { const int sub = item & 15, bh = item >> 4; b = bh / 6; const int head = bh - 6 * b; grp = head >> 1; dil = (grp == 0) ? 1 : (grp == 1 ? 4 : 16);
            const int per = 16 / dil; res = sub / per; m0 = (sub - res * per) * 256; khead = head; qhead = head; ntiles = 6; }
        else if constexpr (MODE == 1) { const int qq = item / 96, qi = item - 96 * qq; const int bh = qq * 6 + (qi >> 4); nblk = 15 - (qi & 15); b = bh / 6; hB = bh - 6 * b; khead = 6 + hB; qhead = 6 + hB; ntiles = 4 * (nblk + 1); }
        else { const int pt = item & 63, bk = item >> 6; b = bk >> 1; const int kvh = bk & 1; m0 = pt * 64; khead = 12 + kvh; qhead = 12 + kvh * 4 + (wave >> 1); ntiles = 3; }
        int qidx, qtok;
        if constexpr (MODE == 0) { qidx = m0 + 32 * wave + r32; qtok = b * SEQ + res + qidx * dil; }
        else if constexpr (MODE == 1) { qidx = 256 * nblk + 32 * wave + r32; qtok = b * SEQ + qidx; }
        else { qidx = m0 + 32 * (wave & 1) + r32; qtok = b * SEQ + qidx; }
        const int q0w = qidx - r32;
        bf16x8 qf[8];
        { const bf16* qp = QKV + (size_t)qtok * NPROJ + qhead * HD + hh * 8;
#pragma unroll
          for (int ks = 0; ks < 8; ++ks) qf[ks] = *(const bf16x8*)(qp + 16 * ks); }
        auto tile_k0 = [&](int ts) -> int {
            if constexpr (MODE == 0) return m0 - 128 + 64 * (5 - ts);
            else if constexpr (MODE == 1) return 256 * (nblk - (ts >> 2)) + 64 * (3 - (ts & 3));
            else return m0 - 128 + 64 * (2 - ts); };
        const unsigned dvo0 = drow[0] * (unsigned)(dil * NPROJ * 2) + 16u * dch[0], dvo1 = drow[1] * (unsigned)(dil * NPROJ * 2) + 16u * dch[1];
        auto dma = [&](int ts, int sl, bool isv) {
            int k0 = tile_k0(ts); k0 = k0 < 0 ? 0 : k0;
            const unsigned so = (unsigned)(b * SEQ + res + k0 * dil) * (unsigned)(NPROJ * 2) + (unsigned)(((isv ? VOFF : KOFF) + khead * HD) * 2);
            LAS unsigned char* dst = lds + KV_OFF + (isv ? V_OFF : 0) + sl * 16384 + wave * 2048;
            __builtin_amdgcn_raw_ptr_buffer_load_lds(rsrc, (LAS void*)dst, 16, (int)dvo0, (int)so, 0, 0);
            __builtin_amdgcn_raw_ptr_buffer_load_lds(rsrc, (LAS void*)(dst + 1024), 16, (int)dvo1, (int)so, 0, 0); };
        dma(0, 0, false); if (ntiles > 1) { dma(1, 1, false); dma(1, 1, true); } if (ntiles > 2) dma(2, 2, false); dma(0, 0, true);
        unsigned selmask = 0u;
        if constexpr (MODE == 1) {
            { const int j = tid >> 5, c = tid & 31; const f32x4* kq = (const f32x4*)(KMEAN + (size_t)((b * 16 + j) * 6 + hB) * 4 * HD + c * 4);
              *(LAS f32x4*)(km + j * 128 + c * 4) = (kq[0] + kq[32]) + (kq[64] + kq[96]); }
            LDS_WAIT(); __syncthreads();
            float v1 = -INFINITY, v2 = -INFINITY, v3 = -INFINITY; int i1 = -1, i2 = -1, i3 = -1;
            for (int j = 0; j < nblk; ++j) {
                float a = 0.f;
#pragma unroll
                for (int ks = 0; ks < 8; ++ks) { const f32x4 k0 = *(const LAS f32x4*)(km + j * 128 + 16 * ks + 8 * hh), k1 = *(const LAS f32x4*)(km + j * 128 + 16 * ks + 8 * hh + 4);
                    const u32x4 qq = __builtin_bit_cast(u32x4, qf[ks]);
                    a += bflo(qq.x) * k0[0] + bfhi(qq.x) * k0[1] + bflo(qq.y) * k0[2] + bfhi(qq.y) * k0[3] + bflo(qq.z) * k1[0] + bfhi(qq.z) * k1[1] + bflo(qq.w) * k1[2] + bfhi(qq.w) * k1[3]; }
                a = xhalf_sum(a);
                if (a > v1) { v3 = v2; i3 = i2; v2 = v1; i2 = i1; v1 = a; i1 = j; }
                else if (a > v2) { v3 = v2; i3 = i2; v2 = a; i2 = j; }
                else if (a > v3) { v3 = a; i3 = j; }
            }
            if (i1 >= 0) selmask |= 1u << i1; if (i2 >= 0) selmask |= 1u << i2; if (i3 >= 0) selmask |= 1u << i3;
        }
        auto params = [&](int ts, bool& active, int& dl, int& dmax, bool& pastb) {
            const int k0 = tile_k0(ts); pastb = false;
            if constexpr (MODE == 1) {
                const int kblk = nblk - (ts >> 2);
                if (kblk == nblk) { active = k0 <= q0w + 31; dl = qidx - (k0 + 8 * hh); dmax = 0x7fffffff; }
                else { const bool sel = (selmask >> kblk) & 1u; active = __ballot(sel) != 0ull; dl = 64; dmax = sel ? 0x7fffffff : 0; pastb = true; }
            } else {
                constexpr int MAXD = (MODE == 0) ? 128 : 127;
                active = (k0 <= q0w + 31) && (k0 + 63 >= q0w - MAXD) && (k0 + 63 >= 0);
                dl = qidx - (k0 + 8 * hh); dmax = qidx < MAXD ? qidx : MAXD;
            } };
        float m_run = -1e30f, l_run = 0.f; f32x16 o[4];
#pragma unroll
        for (int c = 0; c < 4; ++c)
#pragma unroll
            for (int i = 0; i < 16; ++i) o[c][i] = 0.f;
        f32x16 sc; bool act_c = false, act_n = false, pb_c = false, pb_n = false; int dl_c = 0, dmax_c = 0, dl_n = 0, dmax_n = 0;
#pragma unroll
        for (int i = 0; i < 16; ++i) sc[i] = 0.f;
#define ATT_QK(sn, Kb_, half_) do { bf16x8 kf[3]; f32x16 z_; \
            _Pragma("unroll") for (int i_ = 0; i_ < 16; ++i_) z_[i_] = 0.f; \
            _Pragma("unroll") for (int ks_ = 0; ks_ < 3; ++ks_) kf[ks_] = *(const LAS bf16x8*)((Kb_) + 8192 * (half_) + krow + 16u * ((unsigned)(2 * ks_) ^ kz)); \
            __builtin_amdgcn_sched_barrier(0); __builtin_amdgcn_s_setprio(1);        \
            _Pragma("unroll") for (int ks_ = 0; ks_ < 8; ++ks_) { sn = __builtin_amdgcn_mfma_f32_32x32x16_bf16(kf[ks_ % 3], qf[ks_], ks_ == 0 ? z_ : sn, 0, 0, 0); \
                if (ks_ + 3 < 8) kf[ks_ % 3] = *(const LAS bf16x8*)((Kb_) + 8192 * (half_) + krow + 16u * ((unsigned)(2 * (ks_ + 3)) ^ kz)); \
                __builtin_amdgcn_sched_barrier(0); } \
            __builtin_amdgcn_s_setprio(0); } while (0)
#define VTR_ASM(dst_, addr_, OFF_) asm volatile("ds_read_b64_tr_b16 %0, %1 offset:%2" : "=v"(dst_) : "v"(addr_), "n"(OFF_))
#define VTR_WAIT(n_, a_, b_) asm volatile("s_waitcnt lgkmcnt(" #n_ ")" : "+v"(a_), "+v"(b_))
#define ATT_SMPV(Vb_, half_) do { \
            const bool lout_ = (MODE == 1) && pb_c && (dmax_c == 0);        \
            if (MODE != 1 || !pb_c) { const bool fullv_ = (dl_c >= 55) && ((unsigned)dl_c <= (unsigned)dmax_c); \
              if (!__all(fullv_)) { _Pragma("unroll") for (int i_ = 0; i_ < 16; ++i_) { const int c0_ = 32 * (half_) + 16 * (i_ >> 3) + (i_ & 7); sc[i_] = ((unsigned)(dl_c - c0_) <= (unsigned)dmax_c) ? sc[i_] : -INFINITY; } } } \
            float mx_;        \
            { const float m0_ = fmaxf(fmaxf(sc[0], sc[1]), sc[2]), m1_ = fmaxf(fmaxf(sc[3], sc[4]), sc[5]), m2_ = fmaxf(fmaxf(sc[6], sc[7]), sc[8]), m3_ = fmaxf(fmaxf(sc[9], sc[10]), sc[11]), m4_ = fmaxf(fmaxf(sc[12], sc[13]), sc[14]); \
              mx_ = fmaxf(fmaxf(fmaxf(m0_, m1_), m2_), fmaxf(fmaxf(m3_, m4_), sc[15])); } \
            mx_ = lout_ ? -INFINITY : mx_; \
            if (!__all(mx_ - m_run <= 8.f)) { mx_ = xhalf_max(mx_);        \
                const float mn_ = fmaxf(m_run, mx_), al_ = __builtin_amdgcn_exp2f(m_run - mn_); m_run = mn_; l_run *= al_; \
                _Pragma("unroll") for (int c_ = 0; c_ < 4; ++c_) _Pragma("unroll") for (int i_ = 0; i_ < 16; ++i_) o[c_][i_] *= al_; } \
            const float mu_ = lout_ ? INFINITY : m_run;        \
            float ps_ = 0.f; _Pragma("unroll") for (int i_ = 0; i_ < 16; ++i_) { sc[i_] = __builtin_amdgcn_exp2f(sc[i_] - mu_); ps_ += sc[i_]; } l_run += ps_; \
            bf16x8 pk_[2]; _Pragma("unroll") for (int st_ = 0; st_ < 2; ++st_) { u32x4 w_; w_.x = cvt_pk_bf16(sc[8 * st_ + 0], sc[8 * st_ + 1]); w_.y = cvt_pk_bf16(sc[8 * st_ + 2], sc[8 * st_ + 3]); \
                w_.z = cvt_pk_bf16(sc[8 * st_ + 4], sc[8 * st_ + 5]); w_.w = cvt_pk_bf16(sc[8 * st_ + 6], sc[8 * st_ + 7]); pk_[st_] = __builtin_bit_cast(bf16x8, w_); } \
            const unsigned vbu_ = (unsigned)(__UINTPTR_TYPE__)(Vb_); \
            s16x4 va_[4][2]; unsigned vad_[4][2]; \
            _Pragma("unroll") for (int e_ = 0; e_ < 4; ++e_) _Pragma("unroll") for (int tt_ = 0; tt_ < 2; ++tt_) vad_[e_][tt_] = vbu_ + vbase[tt_] + vcq_(e_); \
            _Pragma("unroll") for (int e_ = 0; e_ < 4; ++e_) _Pragma("unroll") for (int tt_ = 0; tt_ < 2; ++tt_) VTR_ASM(va_[e_][tt_], vad_[e_][tt_], 4096 * (2 * (half_))); \
            __builtin_amdgcn_sched_barrier(0); __builtin_amdgcn_s_setprio(1); \
            _Pragma("unroll") for (int e_ = 0; e_ < 8; ++e_) { const int c_ = e_ & 3; \
                if (e_ < 5) VTR_WAIT(6, va_[e_ & 3][0], va_[e_ & 3][1]); else if (e_ == 5) VTR_WAIT(4, va_[e_ & 3][0], va_[e_ & 3][1]); \
                else if (e_ == 6) VTR_WAIT(2, va_[e_ & 3][0], va_[e_ & 3][1]); else VTR_WAIT(0, va_[e_ & 3][0], va_[e_ & 3][1]); \
                const s16x4 a0_ = va_[e_ & 3][0], a1_ = va_[e_ & 3][1]; \
                bf16x8 vf_; vf_[0] = a0_[0]; vf_[1] = a0_[1]; vf_[2] = a0_[2]; vf_[3] = a0_[3]; vf_[4] = a1_[0]; vf_[5] = a1_[1]; vf_[6] = a1_[2]; vf_[7] = a1_[3]; \
                o[c_] = __builtin_amdgcn_mfma_f32_32x32x16_bf16(vf_, pk_[e_ >> 2], o[c_], 0, 0, 0); \
                if (e_ + 4 < 8) { _Pragma("unroll") for (int tt_ = 0; tt_ < 2; ++tt_) VTR_ASM(va_[e_ & 3][tt_], vad_[e_ & 3][tt_], 4096 * (2 * (half_) + 1)); } \
                __builtin_amdgcn_sched_barrier(0); } \
            __builtin_amdgcn_s_setprio(0); } while (0)
        asm volatile("s_waitcnt vmcnt(0)" ::: "memory"); __syncthreads();
        params(0, act_c, dl_c, dmax_c, pb_c);
        if (act_c) { const LAS unsigned char* Kb = lds + KV_OFF; ATT_QK(sc, Kb, 0); }
        int k4 = 0, v3 = 0;
        for (int t = 0; t < ntiles; ++t) {
            const int k4n = (k4 + 1) & 3, v3n = (v3 == 2) ? 0 : v3 + 1;
            const bool issK = t + 3 < ntiles, issV = t + 2 < ntiles;
            if (issK) dma(t + 3, (k4 + 3) & 3, false);
            if (issV) dma(t + 2, (v3 == 0) ? 2 : v3 - 1, true);
            const LAS unsigned char* Kb = lds + KV_OFF + k4 * 16384; const LAS unsigned char* Vb = lds + KV_OFF + V_OFF + v3 * 16384;
            { f32x16 sn; if (act_c) { ATT_QK(sn, Kb, 1); ATT_SMPV(Vb, 0); sc = sn; } }
            { f32x16 sn;
#pragma unroll
              for (int i = 0; i < 16; ++i) sn[i] = 0.f;
              act_n = false;
              if (t + 1 < ntiles) { params(t + 1, act_n, dl_n, dmax_n, pb_n); if (act_n) { const LAS unsigned char* Kn = lds + KV_OFF + k4n * 16384; ATT_QK(sn, Kn, 0); } }
              if (act_c) { ATT_SMPV(Vb, 1); }
              sc = sn; act_c = act_n; dl_c = dl_n; dmax_c = dmax_n; pb_c = pb_n; }
            k4 = k4n; v3 = v3n;
            if (issK && issV) asm volatile("s_waitcnt vmcnt(4)" ::: "memory"); else asm volatile("s_waitcnt vmcnt(0)" ::: "memory");
            LDS_WAIT(); __builtin_amdgcn_s_barrier();
        }
#undef ATT_QK
#undef ATT_SMPV

        { const float l = xhalf_sum(l_run); const float lse2 = m_run + log2f(l); float sc = 1.f / l; bf16* orow;
          if constexpr (MODE == 0) { orow = PA + ((size_t)grp * T + qtok) * 256 + (qhead & 1) * HD; if (hh == 0) LSEA[((size_t)grp * T + qtok) * 2 + (qhead & 1)] = lse2; }
          else if constexpr (MODE == 1) { orow = ATT + (size_t)qtok * D + 256 + hB * HD; }
          else { const int qh = qhead - 12; orow = ATT + (size_t)qtok * D + 1024 + qh * HD; sc *= 1.f / (1.f + expf(sinks[qh] - lse2 * LN2F)); }
          bf16* const orow16 = orow + 8 * hh;
#pragma unroll
          for (int c = 0; c < 4; ++c)
#pragma unroll
              for (int p = 0; p < 2; ++p) { const int g0 = 2 * p, g1 = 2 * p + 1;
                  const unsigned ax = cvt_pk_bf16(o[c][4 * g0] * sc, o[c][4 * g0 + 1] * sc), ay = cvt_pk_bf16(o[c][4 * g0 + 2] * sc, o[c][4 * g0 + 3] * sc);
                  const unsigned bx_ = cvt_pk_bf16(o[c][4 * g1] * sc, o[c][4 * g1 + 1] * sc), by_ = cvt_pk_bf16(o[c][4 * g1 + 2] * sc, o[c][4 * g1 + 3] * sc);
                  const auto rx = __builtin_amdgcn_permlane32_swap(ax, bx_, false, false); const auto ry = __builtin_amdgcn_permlane32_swap(ay, by_, false, false);
                  u32x4 w; w.x = rx[0]; w.y = ry[0]; w.z = rx[1]; w.w = ry[1];
                  *(u32x4*)(orow16 + 32 * c + 16 * p) = w; } }
        if (tid == 0) slot[0] = nxt_local;
        LDS_WAIT(); __syncthreads();
        item = slot[0];
    }
}
}

#define XB_TMO      128
#define XB_XCNT(j)  (256  + 64 * (j))
#define XB_XSUB(j)  (1280 + 64 * (j))
#define XB_XGEN(j)  (2304 + 64 * (j))
#define XB_TOP      3328
#define XB_TOPGEN   3392
#define XCD_BAR_WORDS 3456
#define XB_SPIN_CAP (1u << 18)
__device__ __forceinline__ unsigned xb_ld(unsigned* p)              { return __hip_atomic_load(p, __ATOMIC_RELAXED, __HIP_MEMORY_SCOPE_AGENT); }
__device__ __forceinline__ unsigned xb_add(unsigned* p, unsigned v) { return __hip_atomic_fetch_add(p, v, __ATOMIC_RELAXED, __HIP_MEMORY_SCOPE_AGENT); }
__device__ __forceinline__ unsigned xb_xcc_id() { return (unsigned)__builtin_amdgcn_s_getreg((3 << 11) | 20) & 0xFu; }
#define XB_SPIN(cond, bar) do { unsigned _sp = 0; while (cond) { __builtin_amdgcn_s_sleep(1); \
    if ((++_sp & 255u) == 0u) { if (xb_ld(&(bar)[XB_TMO])) break; if (_sp > XB_SPIN_CAP) { atomicAdd(&(bar)[XB_TMO], 1u); break; } } } } while (0)
struct XcdBarrier { unsigned* bar; unsigned x; volatile LAS unsigned* st; };
__device__ __forceinline__ XcdBarrier xcd_barrier_post(unsigned* bar, volatile LAS unsigned* st) {
    XcdBarrier b; b.bar = bar; b.x = xb_xcc_id(); b.st = st;
    if (threadIdx.x == 0) (void)xb_add(&bar[XB_XCNT(b.x)], 1u);
    return b;
}
__device__ __forceinline__ void xcd_barrier_complete(unsigned* bar, unsigned x, unsigned& nloc, unsigned& nx) {
    const unsigned G = gridDim.x * gridDim.y * gridDim.z;
    unsigned sum, cnt, mine, sp = 0u;
    for (;;) {
        sum = 0u; cnt = 0u; mine = 0u;
#pragma unroll
        for (unsigned j = 0; j < 16; ++j) { const unsigned c = xb_ld(&bar[XB_XCNT(j)]); sum += c; cnt += (c > 0u) ? 1u : 0u; mine = (j == x) ? c : mine; }
        if (sum == G) break;
        __builtin_amdgcn_s_sleep(1);
        if ((++sp & 255u) == 0u) { if (xb_ld(&bar[XB_TMO])) break; if (sp > XB_SPIN_CAP) { atomicAdd(&bar[XB_TMO], 1u); break; } }
    }
    nloc = mine > 0u ? mine : 1u; nx = cnt > 0u ? cnt : 1u;
}
__device__ __forceinline__ void xcd_barrier(const XcdBarrier& b) {
    asm volatile("s_waitcnt vmcnt(0)" ::: "memory");
    __syncthreads();
    if (threadIdx.x == 0) {
        unsigned* bar = b.bar;
        __builtin_amdgcn_s_waitcnt(0);
        unsigned nloc = b.st[0], nx = b.st[1];
        if (nloc == 0u) { xcd_barrier_complete(bar, b.x, nloc, nx); b.st[0] = nloc; b.st[1] = nx; }
        const unsigned old = xb_add(&bar[XB_XSUB(b.x)], 1u);
        const unsigned gen = old / nloc;
        if (old + 1u == (gen + 1u) * nloc) {
            __builtin_amdgcn_fence(__ATOMIC_RELEASE, "agent");
            asm volatile("s_waitcnt vmcnt(0)" ::: "memory");
            const unsigned og = xb_add(&bar[XB_TOP], 1u);
            const unsigned tg = og / nx;
            if (og + 1u == (tg + 1u) * nx) xb_add(&bar[XB_TOPGEN], 1u);
            else XB_SPIN(xb_ld(&bar[XB_TOPGEN]) == tg, bar);
            __builtin_amdgcn_fence(__ATOMIC_ACQUIRE, "agent");
            xb_add(&bar[XB_XGEN(b.x)], 1u);
            asm volatile("s_waitcnt vmcnt(0)" ::: "memory");
        } else {
            XB_SPIN(xb_ld(&bar[XB_XGEN(b.x)]) == gen, bar);
            __builtin_amdgcn_fence(__ATOMIC_ACQUIRE, "agent");
            asm volatile("s_waitcnt vmcnt(0)" ::: "memory");
        }
    }
    __syncthreads();
}

#define dpp_f(v, ctrl) __builtin_bit_cast(float, __builtin_amdgcn_update_dpp(0, __builtin_bit_cast(int, (float)(v)), (ctrl), 0xf, 0xf, true))
__device__ __forceinline__ float wave_sum(float v) {
    v += __builtin_bit_cast(float, __builtin_amdgcn_update_dpp(0, __builtin_bit_cast(int, v), 0xB1, 0xf, 0xf, true));
    v += __builtin_bit_cast(float, __builtin_amdgcn_update_dpp(0, __builtin_bit_cast(int, v), 0x4E, 0xf, 0xf, true));
    v += __builtin_bit_cast(float, __builtin_amdgcn_update_dpp(0, __builtin_bit_cast(int, v), 0x141, 0xf, 0xf, true));
    v += __builtin_bit_cast(float, __builtin_amdgcn_update_dpp(0, __builtin_bit_cast(int, v), 0x140, 0xf, 0xf, true));
    const int iv = __builtin_bit_cast(int, v);
    const float r0 = __builtin_bit_cast(float, __builtin_amdgcn_readlane(iv, 0)), r1 = __builtin_bit_cast(float, __builtin_amdgcn_readlane(iv, 16));
    const float r2 = __builtin_bit_cast(float, __builtin_amdgcn_readlane(iv, 32)), r3 = __builtin_bit_cast(float, __builtin_amdgcn_readlane(iv, 48));
    return (r0 + r1) + (r2 + r3);
}
__device__ __forceinline__ float wave_max(float v) {
#pragma unroll
    for (int o = 1; o < 64; o <<= 1) v = fmaxf(v, __shfl_xor(v, o));
    return v;
}

__device__ __forceinline__ void transpose_item(const float* W, int ldw, bf16* WT, int ldt, int k0, int n0, int dst_row0, LAS float* scr, int lane) {
#pragma unroll 8
    for (int i = 0; i < 32; ++i) { const int kk = 2 * i + (lane >> 5); scr[kk * 33 + (lane & 31)] = W[(size_t)(k0 + kk) * ldw + n0 + (lane & 31)]; }
    LDS_WAIT(); asm volatile("" ::: "memory");
    const int c = lane & 7;
#pragma unroll
    for (int j = 0; j < 4; ++j) { const int n = (lane >> 3) + 8 * j; const LAS float* s = scr + (8 * c) * 33 + n;
        u32x4 o; o.x = pk2(s[0 * 33], s[1 * 33]); o.y = pk2(s[2 * 33], s[3 * 33]); o.z = pk2(s[4 * 33], s[5 * 33]); o.w = pk2(s[6 * 33], s[7 * 33]);
        *(u32x4*)(WT + (size_t)(dst_row0 + n) * ldt + k0 + 8 * c) = o; }
    LDS_WAIT(); asm volatile("" ::: "memory");
}

__device__ __forceinline__ void transpose_item8(const float* W, int ldw, unsigned char* WT, int ldt, int k0, int n0, int dst_row0, LAS float* scr, int lane) {
#pragma unroll 8
    for (int i = 0; i < 32; ++i) { const int kk = 2 * i + (lane >> 5); scr[kk * 33 + (lane & 31)] = W[(size_t)(k0 + kk) * ldw + n0 + (lane & 31)]; }
    LDS_WAIT(); asm volatile("" ::: "memory");
    const int c = lane & 3;
#pragma unroll
    for (int j = 0; j < 2; ++j) { const int n = (lane >> 2) + 16 * j; const LAS float* sp = scr + (16 * c) * 33 + n;
        int w[4];
#pragma unroll
        for (int q = 0; q < 4; ++q) { int t = 0; t = __builtin_amdgcn_cvt_pk_fp8_f32(sp[(4 * q) * 33] * W8_SCALE, sp[(4 * q + 1) * 33] * W8_SCALE, t, false);
            t = __builtin_amdgcn_cvt_pk_fp8_f32(sp[(4 * q + 2) * 33] * W8_SCALE, sp[(4 * q + 3) * 33] * W8_SCALE, t, true); w[q] = t; }
        u32x4 o; o.x = (unsigned)w[0]; o.y = (unsigned)w[1]; o.z = (unsigned)w[2]; o.w = (unsigned)w[3];
        *(u32x4*)(WT + (size_t)(dst_row0 + n) * ldt + k0 + 16 * c) = o; }
    LDS_WAIT(); asm volatile("" ::: "memory");
}


struct WItem { const float* W; int ldw; unsigned char* WT; int ldt; int k0, n0, dst_row0; int f8; };
__device__ __forceinline__ void witem_issue(const WItem& I, float (&r)[32], int lane) {
    const float* p = I.W + (size_t)(I.k0 + (lane >> 5)) * I.ldw + I.n0 + (lane & 31);
#pragma unroll
    for (int i = 0; i < 32; ++i) r[i] = __builtin_nontemporal_load(p + (size_t)(2 * i) * I.ldw);
}
__device__ __forceinline__ void witem_finish(const WItem& I, const float (&r)[32], LAS float* scr, int lane) {
#pragma unroll
    for (int i = 0; i < 32; ++i) { const int kk = 2 * i + (lane >> 5); scr[kk * 33 + (lane & 31)] = r[i]; }
    LDS_WAIT(); asm volatile("" ::: "memory");
    if (I.f8) {
        const int c = lane & 3;
#pragma unroll
        for (int j = 0; j < 2; ++j) { const int n = (lane >> 2) + 16 * j; const LAS float* sp = scr + (16 * c) * 33 + n;
            int w[4];
#pragma unroll
            for (int q = 0; q < 4; ++q) { int t = 0; t = __builtin_amdgcn_cvt_pk_fp8_f32(sp[(4 * q) * 33] * W8_SCALE, sp[(4 * q + 1) * 33] * W8_SCALE, t, false);
                t = __builtin_amdgcn_cvt_pk_fp8_f32(sp[(4 * q + 2) * 33] * W8_SCALE, sp[(4 * q + 3) * 33] * W8_SCALE, t, true); w[q] = t; }
            u32x4 o; o.x = (unsigned)w[0]; o.y = (unsigned)w[1]; o.z = (unsigned)w[2]; o.w = (unsigned)w[3];
            *(u32x4*)(I.WT + (size_t)(I.dst_row0 + n) * I.ldt + I.k0 + 16 * c) = o; }
    } else {
        const int c = lane & 7; bf16* WTb = (bf16*)I.WT;
#pragma unroll
        for (int j = 0; j < 4; ++j) { const int n = (lane >> 3) + 8 * j; const LAS float* sq = scr + (8 * c) * 33 + n;
            u32x4 o; o.x = pk2(sq[0 * 33], sq[1 * 33]); o.y = pk2(sq[2 * 33], sq[3 * 33]); o.z = pk2(sq[4 * 33], sq[5 * 33]); o.w = pk2(sq[6 * 33], sq[7 * 33]);
            *(u32x4*)(WTb + (size_t)(I.dst_row0 + n) * I.ldt + I.k0 + 8 * c) = o; }
    }
    LDS_WAIT(); asm volatile("" ::: "memory");
}

struct Args {
    const float* x; const int* pos; const float* w_in; const float* w_gate; const float* b_gate; const float* w_br_a; const float* w_br_b; const float* w_br_c;
    const float* w_out; const float* sinks; const float* ln1_g; const float* ln1_b; const float* w_rg; const float* w_re; const float* w_eg; const float* w_eu; const float* w_ed;
    const float* ln2_g; const float* ln2_b; float* out; unsigned char* ws; int ph_lo, ph_hi, li, pad;
};

__global__ void __launch_bounds__(512, 2) mega_fwd(Args args) {
    extern __shared__ __attribute__((aligned(16))) unsigned char lds_raw[];
    LAS unsigned char* lds = (LAS unsigned char*)lds_raw;
    volatile LAS unsigned* MISC = (volatile LAS unsigned*)(lds + MISC_OFF);
    const int tid0 = threadIdx.x;
    const int wave0_ = __builtin_amdgcn_readfirstlane(tid0 >> 6);
    typedef const __attribute__((address_space(4))) Args CArgs;
    CArgs* ka0 = (CArgs*)__builtin_amdgcn_kernarg_segment_ptr();
#define KA() ({ CArgs* _p = ka0; asm volatile("" : "+s"(_p)); _p; })
    unsigned char* ws0 = KA()->ws;
    unsigned* ctl = (unsigned*)(ws0 + WS_CTL);
    for (int u = tid0; u < (LDS_BYTES - LDSCTL_OFF) / 4; u += 512) ((LAS unsigned*)(lds + LDSCTL_OFF))[u] = 0u;
    __syncthreads();
#if MK_ONE_LAUNCH
    XcdBarrier bar = xcd_barrier_post(ctl + CW_BAR + KA()->li * XCD_BAR_WORDS, MISC + 8);
#define GRID_BAR() xcd_barrier(bar)
#else
#define GRID_BAR() do { if (tid0 == 0) __hip_atomic_store(ctl + 0, 0xBADBA0u, __ATOMIC_RELAXED, __HIP_MEMORY_SCOPE_AGENT); } while (0)
#endif
    const int lo = KA()->ph_lo, hi = KA()->ph_hi;
#ifndef PHSEL
#define PHSEL 0x1FFF
#endif
#define IN(k) (((PHSEL >> ((k) % NPH)) & 1) && lo <= (k) && (k) < hi)
#define SEAM(k) do { if (IN(k) && IN((k) + 1)) GRID_BAR(); } while (0)

#define PHASE_PTRS() unsigned z0_ = 0u; asm volatile("" : "+v"(z0_)); int tid = wave0_ * 64 + (int)__builtin_amdgcn_mbcnt_hi(~0u, __builtin_amdgcn_mbcnt_lo(~0u, z0_)); const int lane = tid & 63, wave = __builtin_amdgcn_readfirstlane(tid >> 6); (void)lane; (void)wave; \
    int bx = blockIdx.x; asm volatile("" : "+s"(bx)); int G = gridDim.x; asm volatile("" : "+s"(G)); \
    const int vcu = (G % 8 == 0) ? (bx % 8) * (G / 8) + bx / 8 : bx; const int gw = vcu * 8 + wave, NGW = G * 8; (void)gw; (void)NGW; \
    CArgs* const A_ = KA(); unsigned char* const ws = A_->ws; (void)ws; \
    bf16* const Wb = (bf16*)(ws + WS_W); bf16* const HB = (bf16*)(ws + WS_HB); unsigned char* const W8 = ws + WS_W; unsigned char* const HB8 = ws + WS_HB8; unsigned char* const HID8 = ws + WS_R2; (void)W8; (void)HB8; (void)HID8; \
    bf16* const QKV = (bf16*)(ws + WS_R1); bf16* const GATES = (bf16*)(ws + WS_R1); float* const MIX = (float*)(ws + WS_R1); bf16* const YB = (bf16*)(ws + WS_R1); \
    bf16* const ATT = (bf16*)(ws + WS_R2); bf16* const HID = (bf16*)(ws + WS_R2); bf16* const MERGED = (bf16*)(ws + WS_R3); \
    float* const ROPE = (float*)(ws + WS_ROPE); \
    int* const route_e = (int*)(ws + WS_ROUTE_E); float* const route_w = (float*)(ws + WS_ROUTE_W + (size_t)l * 4 * MiB); \
    int* const row_tok = (int*)(ws + WS_ROWTOK); int* const row_dst = (int*)(ws + WS_ROWDST + (size_t)l * 4 * MiB); float* const row_w = (float*)(ws + WS_ROWW); \
    int* const cnt_wg = (int*)(ws + WS_CNTWG); int* const tile_off_g = (int*)(ws + WS_TILEOFF); float* const KMEAN = (float*)(ws + WS_KMEAN); \
    (void)Wb; (void)HB; (void)QKV; (void)GATES; (void)MIX; (void)YB; (void)ATT; (void)HID; (void)MERGED; (void)ROPE; (void)route_e; (void)route_w; (void)row_tok; (void)row_dst; (void)row_w; (void)cnt_wg; (void)tile_off_g; (void)KMEAN; \
    const float* const hin = (l == 0) ? A_->x : A_->out; (void)hin;
    if (IN(0)) { const int l = 0; PHASE_PTRS();
                for (int idx = (bx * 512 + tid); idx < T * 64; idx += G * 512) {
                    const int t = idx >> 6, i = idx & 63;
                    const float inv = (float)pow(10000.0, -(double)(2 * i) / 128.0);
                    const float ang = (float)A_->pos[t] * inv;
                    double sn, cs; sincos((double)ang, &sn, &cs);
                    ROPE[(size_t)t * 128 + i] = (float)cs; ROPE[(size_t)t * 128 + 64 + i] = (float)sn;
                }
                for (size_t i8 = (size_t)bx * 512 + tid; i8 < (size_t)T * D / 8; i8 += (size_t)G * 512) {
                    const f32x4 a = __builtin_nontemporal_load((const f32x4*)(A_->x + i8 * 8)), b = __builtin_nontemporal_load((const f32x4*)(A_->x + i8 * 8 + 4));
                    { int t0 = 0, t1 = 0; t0 = __builtin_amdgcn_cvt_pk_fp8_f32(a[0], a[1], t0, false); t0 = __builtin_amdgcn_cvt_pk_fp8_f32(a[2], a[3], t0, true);
                      t1 = __builtin_amdgcn_cvt_pk_fp8_f32(b[0], b[1], t1, false); t1 = __builtin_amdgcn_cvt_pk_fp8_f32(b[2], b[3], t1, true);
                      *(u32x2*)(HB8 + i8 * 8) = (u32x2){(unsigned)t0, (unsigned)t1}; }
                }
            }
    for (int l = 0; l < DEPTH; ++l) {
        const int pb = l * NPH;
        if (IN(pb + 0)) REP(0) { PHASE_PTRS();
            LAS float* scr = (LAS float*)(lds + wave * 16384);
            const float* w_in = A_->w_in + (size_t)l * D * NPROJ; const float* w_gate = A_->w_gate + (size_t)l * D * NPROJ;
            const float* w_a = A_->w_br_a + (size_t)l * 256 * D; const float* w_b = A_->w_br_b + (size_t)l * 768 * D; const float* w_c = A_->w_br_c + (size_t)l * 1024 * D;
            const float* w_out = A_->w_out + (size_t)l * D * D;
            const float* w_eg = A_->w_eg + (size_t)l * NEXP * D * DEXP; const float* w_eu = A_->w_eu + (size_t)l * NEXP * D * DEXP; const float* w_ed = A_->w_ed + (size_t)l * NEXP * DEXP * D;
            constexpr int I_IN = 32 * 192, I_A = 4 * 64, I_B = 12 * 64, I_C = 16 * 64, I_OUT = 32 * 64, I_E = 1024;
            constexpr int NITEMS = 2 * I_IN + I_A + I_B + I_C + I_OUT + 3 * NEXP * I_E;
            auto decode = [&](int it, WItem& I) {
                int r = it;
                if (r < I_IN) { const int kb = r / 192, nb = r % 192, n0 = nb * 32, head = n0 >> 7, d0 = n0 & 127;
                    const int rho = 256 * (head >> 1) + 128 * (d0 >> 6) + 64 * (head & 1) + (d0 & 63);
                    I = WItem{w_in, NPROJ, W8 + W8_IN, D, kb * 64, n0, rho, 1}; return; } r -= I_IN;
                if (r < I_IN) { const int kb = r / 192, nb = r % 192; I = WItem{w_gate, NPROJ, W8 + W8_GATE, D, kb * 64, nb * 32, nb * 32, 1}; return; } r -= I_IN;
                if (r < I_A) { const int kb = r / 64, nb = r % 64; I = WItem{w_a, D, (unsigned char*)(Wb + WO_BR + 0), D, kb * 64, nb * 32, nb * 32, 0}; return; } r -= I_A;
                if (r < I_B) { const int kb = r / 64, nb = r % 64; I = WItem{w_b, D, (unsigned char*)(Wb + WO_BR + 256), D, kb * 64, nb * 32, nb * 32, 0}; return; } r -= I_B;
                if (r < I_C) { const int kb = r / 64, nb = r % 64; I = WItem{w_c, D, (unsigned char*)(Wb + WO_BR + 1024), D, kb * 64, nb * 32, nb * 32, 0}; return; } r -= I_C;
                if (r < I_OUT) { const int kb = r / 64, nb = r % 64; I = WItem{w_out, D, (unsigned char*)(Wb + WO_OUT), D, kb * 64, nb * 32, nb * 32, 0}; return; } r -= I_OUT;
                if (r < NEXP * I_E) { const int e = r / I_E, q = r % I_E, kb = q / 32, nb = q % 32, j0 = nb * 32;
                    I = WItem{w_eg + (size_t)e * D * DEXP, DEXP, W8 + W8_GU + (size_t)e * 2048 * D, D, kb * 64, j0, 256 * (j0 >> 7) + (j0 & 127), 1}; return; } r -= NEXP * I_E;
                if (r < NEXP * I_E) { const int e = r / I_E, q = r % I_E, kb = q / 32, nb = q % 32, j0 = nb * 32;
                    I = WItem{w_eu + (size_t)e * D * DEXP, DEXP, W8 + W8_GU + (size_t)e * 2048 * D, D, kb * 64, j0, 256 * (j0 >> 7) + 128 + (j0 & 127), 1}; return; } r -= NEXP * I_E;
                { const int e = r / I_E, q = r % I_E, kb = q / 64, nb = q % 64;
                    I = WItem{w_ed + (size_t)e * DEXP * D, D, W8 + W8_DN + (size_t)e * D * DEXP, DEXP, kb * 64, nb * 32, nb * 32, 1}; } };
            float rc[32];
            int it = gw;
            { WItem I; decode(it < NITEMS ? it : 0, I); witem_issue(I, rc, lane); }
            while (it < NITEMS) {
                const int itn = it + NGW; float rn[32];
                { WItem I; decode(itn < NITEMS ? itn : it, I); witem_issue(I, rn, lane); }
                { WItem I; decode(it, I); witem_finish(I, rc, scr, lane); }
                it = itn;
#pragma unroll
                for (int i = 0; i < 32; ++i) rc[i] = rn[i];
            }
        }
        SEAM(pb + 0);
        if (IN(pb + 1)) REP(1) { PHASE_PTRS();
            pg8::SchedDense S{(const char*)HB8, (const char*)(W8 + W8_IN), D, D, T / 256, NPROJ / 256, G, bx, D / 128};
            pg8::EpiRope E{QKV, ROPE, W8_INV};
            pg8::gemm_phase<pg8::EpiRope, pg8::SchedDense, true, false, true>(lds, S, E, tid);
        }
        SEAM(pb + 1);
        if (IN(pb + 2)) REP(2) { PHASE_PTRS();
            for (int it4 = gw; it4 < NBATCH * 16 * 6 * 4; it4 += NGW) {
                const int qr = it4 & 3, it = it4 >> 2; const int h = it % 6, blk = (it / 6) % 16, b = it / 96;
                const bf16* kp = QKV + (size_t)(b * SEQ + blk * 256 + qr * 64 + (lane >> 5)) * NPROJ + KOFF + (6 + h) * HD + 4 * (lane & 31);
                f32x4 a = (f32x4){0.f, 0.f, 0.f, 0.f};
#pragma unroll 8
                for (int i = 0; i < 32; ++i) { const u32x2 w = *(const u32x2*)(kp + (size_t)(2 * i) * NPROJ); a += (f32x4){bflo(w.x), bfhi(w.x), bflo(w.y), bfhi(w.y)}; }
#pragma unroll
                for (int e = 0; e < 4; ++e) a[e] += __shfl_xor(a[e], 32);
                if (lane < 32) *(f32x4*)(KMEAN + ((size_t)it * 4 + qr) * HD + 4 * lane) = a * (1.f / 256.f);
            }
        }
        SEAM(pb + 2);
        if (IN(pb + 3)) REP(3) { PHASE_PTRS();
            bf16* PA = (bf16*)(ws + WS_R3); float* LSEA = (float*)(ws + WS_R3 + 64 * MiB);
            unsigned* ctl_ = (unsigned*)(ws + WS_CTL);
            if (!((ATT_NAIVE_MASK >> 1) & 1)) att::attn_queue<1>(lds, QKV, ATT, PA, LSEA, KMEAN, A_->sinks + l * 8, ctl_ + 1024 + l * 128 + rep_ * 256, tid);
            if (!((ATT_NAIVE_MASK >> 2) & 1)) att::attn_queue<2>(lds, QKV, ATT, PA, LSEA, KMEAN, A_->sinks + l * 8, ctl_ + 64 * (8 + l * 4 + 2 + 16 * rep_), tid);
            if (!((ATT_NAIVE_MASK >> 0) & 1)) att::attn_queue<0>(lds, QKV, ATT, PA, LSEA, KMEAN, A_->sinks + l * 8, ctl_ + 64 * (8 + l * 4 + 0 + 16 * rep_), tid);
#if ATT_NAIVE_MASK
            __syncthreads();
            {
            LAS float* sc = (LAS float*)(lds + wave * 6144);
            LAS float* qf = (LAS float*)(lds + wave * 6144 + 4608 + 512);
            const float* sinks = A_->sinks + l * 8;
            for (int it = gw; it < T * 16; it += NGW) {
                const int slot = it / T, t = it - slot * T, b = t / SEQ, s = t - b * SEQ;
                { const int md = slot < 2 ? 0 : (slot < 8 ? 1 : 2); if (!((ATT_NAIVE_MASK >> md) & 1)) continue; }
                auto qdot = [&](const bf16* krow) -> float {
                    const u32x4* kp = (const u32x4*)krow; float a = 0.f;
#pragma unroll
                    for (int c = 0; c < 16; ++c) { const u32x4 kv = kp[c]; const f32x4 q0 = *(const LAS f32x4*)(qf + 8 * c), q1 = *(const LAS f32x4*)(qf + 8 * c + 4);
                        a += bflo(kv.x) * q0[0] + bfhi(kv.x) * q0[1] + bflo(kv.y) * q0[2] + bfhi(kv.y) * q0[3] + bflo(kv.z) * q1[0] + bfhi(kv.z) * q1[1] + bflo(kv.w) * q1[2] + bfhi(kv.w) * q1[3]; }
                    return a; };
                auto load_q = [&](int qh) { const unsigned w = *(const unsigned*)(QKV + (size_t)t * NPROJ + qh * HD + 2 * lane); qf[2 * lane] = bflo(w); qf[2 * lane + 1] = bfhi(w); LDS_WAIT(); };
                float o0 = 0.f, o1 = 0.f;
                if (slot < 2) {
                    float mx = -INFINITY;
                    for (int g = 0; g < 3; ++g) { const int dil = (g == 0) ? 1 : (g == 1 ? 4 : 16), head = 2 * g + slot;
                        load_q(head);
                        for (int r = 0; r < 3; ++r) { const int i = r * 64 + lane; if (i <= 128) { const int kpos = s - i * dil; float v = -INFINITY;
                                if (kpos >= 0) v = qdot(QKV + (size_t)(b * SEQ + kpos) * NPROJ + KOFF + head * HD);
                                sc[g * 129 + i] = v; mx = fmaxf(mx, v); } }
                        LDS_WAIT(); }
                    mx = wave_max(mx); float lsum = 0.f;
                    for (int i = lane; i < 387; i += 64) { const float p = exp2f(sc[i] - mx); sc[i] = p; lsum += p; }
                    lsum = wave_sum(lsum); LDS_WAIT();
                    for (int g = 0; g < 3; ++g) { const int dil = (g == 0) ? 1 : (g == 1 ? 4 : 16), head = 2 * g + slot;
                        const int imax = min(128, s / dil);
                        const bf16* vp = QKV + (size_t)(b * SEQ + s) * NPROJ + VOFF + head * HD + 2 * lane;
                        _Pragma("unroll 8") for (int i = 0; i <= imax; ++i) { const float p = sc[g * 129 + i]; const unsigned w = *(const unsigned*)(vp - (size_t)i * dil * NPROJ); o0 += p * bflo(w); o1 += p * bfhi(w); } }
                    const float inv = 1.f / lsum;
                    *(unsigned*)(ATT + (size_t)t * D + slot * HD + 2 * lane) = pk2(o0 * inv, o1 * inv);
                } else if (slot < 8) {
                    const int h = slot - 2, blk = s >> 8, head = 6 + h;
                    load_q(head);
                    float gate = -INFINITY;
                    if (lane < blk) { const f32x4* km = (const f32x4*)(KMEAN + (size_t)((b * 16 + lane) * 6 + h) * HD); float a = 0.f;
#pragma unroll 8
                        for (int c = 0; c < 32; ++c) { const f32x4 kv = km[c]; const f32x4 q0 = *(const LAS f32x4*)(qf + 4 * c); a += kv[0] * q0[0] + kv[1] * q0[1] + kv[2] * q0[2] + kv[3] * q0[3]; }
                        gate = a; }
                    int sel[3]; const int nsel = min(3, blk);
                    for (int r = 0; r < 3; ++r) { sel[r] = 0;
                        if (r < nsel) { const float mxg = wave_max(gate); const unsigned long long bal = __ballot(gate == mxg); const int w = __ffsll((long long)bal) - 1; sel[r] = w; if (lane == w) gate = -INFINITY; } }
                    float mx = -INFINITY;
                    const int nown = (s & 255) + 1;
                    for (int r = 0; r < 4; ++r) { const int i = r * 64 + lane; float v = -INFINITY;
                        if (i < nown) v = qdot(QKV + (size_t)(b * SEQ + blk * 256 + i) * NPROJ + KOFF + head * HD);
                        sc[i] = v; mx = fmaxf(mx, v); }
                    for (int q = 0; q < nsel; ++q) for (int r = 0; r < 4; ++r) { const int i = r * 64 + lane;
                        const float v = qdot(QKV + (size_t)(b * SEQ + sel[q] * 256 + i) * NPROJ + KOFF + head * HD);
                        sc[256 + q * 256 + i] = v; mx = fmaxf(mx, v); }
                    LDS_WAIT();
                    mx = wave_max(mx); float lsum = 0.f; const int ntot = 256 + nsel * 256;
                    for (int i = lane; i < ntot; i += 64) { const float p = exp2f(sc[i] - mx); sc[i] = p; lsum += p; }
                    lsum = wave_sum(lsum); LDS_WAIT();
                    { const bf16* vp = QKV + (size_t)(b * SEQ + blk * 256) * NPROJ + VOFF + head * HD + 2 * lane;
                      _Pragma("unroll 8") for (int i = 0; i < nown; ++i) { const float p = sc[i]; const unsigned w = *(const unsigned*)(vp + (size_t)i * NPROJ); o0 += p * bflo(w); o1 += p * bfhi(w); } }
                    for (int q = 0; q < nsel; ++q) { const bf16* vp = QKV + (size_t)(b * SEQ + sel[q] * 256) * NPROJ + VOFF + head * HD + 2 * lane;
                        _Pragma("unroll 16") for (int i = 0; i < 256; ++i) { const float p = sc[256 + q * 256 + i]; const unsigned w = *(const unsigned*)(vp + (size_t)i * NPROJ); o0 += p * bflo(w); o1 += p * bfhi(w); } }
                    const float inv = 1.f / lsum;
                    *(unsigned*)(ATT + (size_t)t * D + 256 + h * HD + 2 * lane) = pk2(o0 * inv, o1 * inv);
                } else {
                    const int qh = slot - 8, head_q = 12 + qh, head_kv = 12 + (qh >> 2);
                    load_q(head_q);
                    float mx = -INFINITY;
                    for (int r = 0; r < 2; ++r) { const int i = r * 64 + lane; const int kpos = s - i; float v = -INFINITY;
                        if (kpos >= 0) v = qdot(QKV + (size_t)(b * SEQ + kpos) * NPROJ + KOFF + head_kv * HD);
                        sc[i] = v; mx = fmaxf(mx, v); }
                    LDS_WAIT();
                    mx = wave_max(mx); float lsum = 0.f;
                    for (int i = lane; i < 128; i += 64) { const float p = exp2f(sc[i] - mx); sc[i] = p; lsum += p; }
                    lsum = wave_sum(lsum); LDS_WAIT();
                    const int imax = min(127, s);
                    const bf16* vp = QKV + (size_t)(b * SEQ + s) * NPROJ + VOFF + head_kv * HD + 2 * lane;
                    _Pragma("unroll 8") for (int i = 0; i <= imax; ++i) { const float p = sc[i]; const unsigned w = *(const unsigned*)(vp - (size_t)i * NPROJ); o0 += p * bflo(w); o1 += p * bfhi(w); }
                    const float lse = (mx + log2f(lsum)) * LN2F;
                    const float keep = 1.f / (1.f + expf(sinks[qh] - lse)) / lsum;
                    *(unsigned*)(ATT + (size_t)t * D + 1024 + qh * HD + 2 * lane) = pk2(o0 * keep, o1 * keep);
                }
                LDS_WAIT();
            }
            }
#endif
        }
        SEAM(pb + 3);
        if (IN(pb + 4)) REP(4) { PHASE_PTRS();
            if (!((ATT_NAIVE_MASK >> 0) & 1)) {
              const bf16* PA = (const bf16*)(ws + WS_R3); const float* LSEA = (const float*)(ws + WS_R3 + 64 * MiB);
              for (int i = bx * 512 + tid; i < T * 32; i += G * 512) { const int t = i >> 5, c8 = i & 31, j = c8 >> 4;
                  const float l0 = LSEA[(size_t)t * 2 + j], l1 = LSEA[((size_t)T + t) * 2 + j], l2 = LSEA[((size_t)2 * T + t) * 2 + j];
                  const float mx = fmaxf(l0, fmaxf(l1, l2)); float w0 = exp2f(l0 - mx), w1 = exp2f(l1 - mx), w2 = exp2f(l2 - mx); const float inv = 1.f / (w0 + w1 + w2); w0 *= inv; w1 *= inv; w2 *= inv;
                  const u32x4 a = *(const u32x4*)(PA + (size_t)t * 256 + c8 * 8), bq = *(const u32x4*)(PA + ((size_t)T + t) * 256 + c8 * 8), cq = *(const u32x4*)(PA + ((size_t)2 * T + t) * 256 + c8 * 8);
                  u32x4 o; o.x = pk2(w0 * bflo(a.x) + w1 * bflo(bq.x) + w2 * bflo(cq.x), w0 * bfhi(a.x) + w1 * bfhi(bq.x) + w2 * bfhi(cq.x));
                  o.y = pk2(w0 * bflo(a.y) + w1 * bflo(bq.y) + w2 * bflo(cq.y), w0 * bfhi(a.y) + w1 * bfhi(bq.y) + w2 * bfhi(cq.y));
                  o.z = pk2(w0 * bflo(a.z) + w1 * bflo(bq.z) + w2 * bflo(cq.z), w0 * bfhi(a.z) + w1 * bfhi(bq.z) + w2 * bfhi(cq.z));
                  o.w = pk2(w0 * bflo(a.w) + w1 * bflo(bq.w) + w2 * bflo(cq.w), w0 * bfhi(a.w) + w1 * bfhi(bq.w) + w2 * bfhi(cq.w));
                  *(u32x4*)(ATT + (size_t)t * D + c8 * 8) = o; }
            }
            pg8::SchedDense S{(const char*)HB8, (const char*)(W8 + W8_GATE), D, D, T / 256, NPROJ / 256, G, bx, D / 128};
            pg8::EpiGate E{(unsigned char*)GATES, A_->b_gate + (size_t)l * NPROJ, W8_INV};
            pg8::gemm_phase<pg8::EpiGate, pg8::SchedDense, true, false, true>(lds, S, E, tid);
        }
        SEAM(pb + 4);
        if (IN(pb + 5)) REP(5) { PHASE_PTRS();
            pg8::SchedDense S{(const char*)ATT, (const char*)(Wb + WO_BR), D * 2, D * 2, T / 256, D / 256, G, bx, D / 64};
            pg8::EpiMerge E{(const unsigned char*)GATES, MERGED};
            pg8::gemm_phase<pg8::EpiMerge, pg8::SchedDense, true, false>(lds, S, E, tid);
        }
        SEAM(pb + 5);
        if (IN(pb + 6)) REP(6) { PHASE_PTRS();
            pg8::SchedDense S{(const char*)MERGED, (const char*)(Wb + WO_OUT), D * 2, D * 2, T / 256, D / 256, G, bx, D / 64};
            pg8::EpiDown E{(bf16*)MIX, 1.f};
            pg8::gemm_phase<pg8::EpiDown, pg8::SchedDense, true, false>(lds, S, E, tid);
        }
        SEAM(pb + 6);
        if (IN(pb + 7)) { PHASE_PTRS();
            LAS f32x4* WeL = (LAS f32x4*)lds;
            LAS f32x4* WgL = (LAS f32x4*)(lds + RING_BYTES);
            LAS int* lcnt = (LAS int*)(lds + LDSCTL_OFF + 512);
            const float* g1 = A_->ln1_g + l * D; const float* b1 = A_->ln1_b + l * D;
            const float* wrg = A_->w_rg + (size_t)l * D * 4; const float* wre = A_->w_re + (size_t)l * D * 16;
            const bf16* MIXB = (const bf16*)MIX;
            for (int idx = tid; idx < 8192; idx += 512) { const int ln = idx & 63, c4 = (idx >> 6) & 3, je = idx >> 8; const int k = 4 * ln + 256 * (je >> 2) + (je & 3);
                WeL[idx] = *(const f32x4*)(wre + (size_t)k * 16 + c4 * 4); }
            for (int idx = tid; idx < 31 * 64; idx += 512) { const int ln = idx & 63, je = idx >> 6; const int k = 4 * ln + 256 * (je >> 2) + (je & 3);
                WgL[idx] = *(const f32x4*)(wrg + (size_t)k * 4); }
            const f32x4 wg31 = *(const f32x4*)(wrg + (size_t)(4 * lane + 256 * 7 + 3) * 4);
            f32x4 gR[8], bR[8];
#pragma unroll
            for (int j = 0; j < 8; ++j) { gR[j] = *((const f32x4*)g1 + lane + 64 * j); bR[j] = *((const f32x4*)b1 + lane + 64 * j); }
            if (tid < 16) lcnt[tid] = 0;
            LDS_WAIT(); __syncthreads();
            for (int tb = bx * 128; tb < T; tb += G * 128) {
              f32x4 hn[8]; u32x2 mn[8];
              auto fetch = [&](int t) { const f32x4* hp = (const f32x4*)(hin + (size_t)t * D) + lane; const u32x2* mp = (const u32x2*)(MIXB + (size_t)t * D) + lane;
#pragma unroll
                for (int j = 0; j < 8; ++j) { hn[j] = __builtin_nontemporal_load(hp + 64 * j); mn[j] = __builtin_nontemporal_load(mp + 64 * j); } };
              fetch(tb + wave * 16);
              auto do_row = [&](const int r) { const int t = tb + wave * 16 + r;
                f32x4 v[8]; float sm = 0.f;
#pragma unroll
                for (int j = 0; j < 8; ++j) { const u32x2 mm = mn[j]; v[j] = hn[j] * DN_ALPHA + (f32x4){bflo(mm.x), bfhi(mm.x), bflo(mm.y), bfhi(mm.y)}; sm += (v[j][0] + v[j][1]) + (v[j][2] + v[j][3]); }
                fetch(r < 15 ? t + 1 : t);
                const float mean = wave_sum(sm) * (1.f / D); float s2 = 0.f;
#pragma unroll
                for (int j = 0; j < 8; ++j) { v[j] = v[j] - mean; s2 += (v[j][0] * v[j][0] + v[j][1] * v[j][1]) + (v[j][2] * v[j][2] + v[j][3] * v[j][3]); }
                const float rstd = 1.f / sqrtf(wave_sum(s2) * (1.f / D) + LN_EPS);
                f32x4* op = (f32x4*)(A_->out + (size_t)t * D) + lane; unsigned* o8 = (unsigned*)(HB8 + (size_t)t * D) + lane;
                float pe[16], pg[4];
#pragma unroll
                for (int c = 0; c < 16; ++c) pe[c] = 0.f;
#pragma unroll
                for (int c = 0; c < 4; ++c) pg[c] = 0.f;
#pragma unroll
                for (int j = 0; j < 8; ++j) {
                    const f32x4 y = v[j] * rstd * gR[j] + bR[j]; op[64 * j] = y;
                    int t0 = 0; t0 = __builtin_amdgcn_cvt_pk_fp8_f32(y[0], y[1], t0, false); t0 = __builtin_amdgcn_cvt_pk_fp8_f32(y[2], y[3], t0, true); o8[64 * j] = (unsigned)t0;
#pragma unroll
                    for (int e = 0; e < 4; ++e) { const float x = y[e];
#pragma unroll
                        for (int c4 = 0; c4 < 4; ++c4) { const f32x4 w = WeL[((j * 4 + e) * 4 + c4) * 64 + lane]; pe[4 * c4] += x * w[0]; pe[4 * c4 + 1] += x * w[1]; pe[4 * c4 + 2] += x * w[2]; pe[4 * c4 + 3] += x * w[3]; }
                        const f32x4 wg = (j * 4 + e < 31) ? WgL[(j * 4 + e) * 64 + lane] : wg31; pg[0] += x * wg[0]; pg[1] += x * wg[1]; pg[2] += x * wg[2]; pg[3] += x * wg[3]; } }
#pragma unroll
                for (int i = 0; i < 8; ++i) { const bool hi = lane & 32; const float snd = hi ? pe[i] : pe[i + 8], keep = hi ? pe[i + 8] : pe[i]; pe[i] = keep + __shfl_xor(snd, 32); }
#pragma unroll
                for (int i = 0; i < 4; ++i) { const bool hi = lane & 16; const float snd = hi ? pe[i] : pe[i + 4], keep = hi ? pe[i + 4] : pe[i]; pe[i] = keep + __shfl_xor(snd, 16); }
#pragma unroll
                for (int i = 0; i < 2; ++i) { const bool hi = lane & 8; const float snd = hi ? pe[i] : pe[i + 2], keep = hi ? pe[i + 2] : pe[i]; pe[i] = keep + __shfl_xor(snd, 8); }
                { const bool hi = lane & 4; const float snd = hi ? pe[0] : pe[1], keep = hi ? pe[1] : pe[0]; pe[0] = keep + __shfl_xor(snd, 4); }
                pe[0] += dpp_f(pe[0], 0x4E); pe[0] += dpp_f(pe[0], 0xB1);
#pragma unroll
                for (int i = 0; i < 2; ++i) { const bool hi = lane & 32; const float snd = hi ? pg[i] : pg[i + 2], keep = hi ? pg[i + 2] : pg[i]; pg[i] = keep + __shfl_xor(snd, 32); }
                { const bool hi = lane & 16; const float snd = hi ? pg[0] : pg[1], keep = hi ? pg[1] : pg[0]; pg[0] = keep + __shfl_xor(snd, 16); }
                pg[0] += dpp_f(pg[0], 0xB1); pg[0] += dpp_f(pg[0], 0x4E); pg[0] += dpp_f(pg[0], 0x141); pg[0] += dpp_f(pg[0], 0x140);
                float a[20];
#pragma unroll
                for (int c = 0; c < 4; ++c) a[c] = __builtin_bit_cast(float, __builtin_amdgcn_readlane(__builtin_bit_cast(int, pg[0]), 16 * c));
#pragma unroll
                for (int c = 0; c < 16; ++c) a[4 + c] = __builtin_bit_cast(float, __builtin_amdgcn_readlane(__builtin_bit_cast(int, pe[0]), 4 * c));
                {
                    int gs = 0; float gm = a[0];
#pragma unroll
                    for (int c = 1; c < 4; ++c) if (a[c] > gm) { gm = a[c]; gs = c; }
                    float den = 0.f;
#pragma unroll
                    for (int c = 0; c < 4; ++c) den += expf(a[c] - gm);
                    const float gval = 1.f / den;
                    float el[4];
#pragma unroll
                    for (int c = 0; c < 4; ++c) el[c] = (gs == 0) ? a[4 + c] : (gs == 1) ? a[8 + c] : (gs == 2) ? a[12 + c] : a[16 + c];
                    int e0 = 0; float v0 = el[0];
#pragma unroll
                    for (int c = 1; c < 4; ++c) if (el[c] > v0) { v0 = el[c]; e0 = c; }
                    int e1 = (e0 == 0) ? 1 : 0; float v1 = el[e1];
#pragma unroll
                    for (int c = 0; c < 4; ++c) if (c != e0 && el[c] > v1) { v1 = el[c]; e1 = c; }
                    const float p1 = expf(v1 - v0), w0 = gval / (1.f + p1), w1 = gval * p1 / (1.f + p1);
                    const int ge0 = gs * 4 + e0, ge1 = gs * 4 + e1;
                    if (lane == 0) { *(int2*)(route_e + (size_t)t * 2) = make_int2(ge0, ge1); *(f32x2*)(route_w + (size_t)t * 2) = (f32x2){w0, w1};
                        atomicAdd((int*)(lcnt + ge0), 1); atomicAdd((int*)(lcnt + ge1), 1); }
                }
              };
              do_row(0);
              for (int r = 1; r < 16; ++r) do_row(r);
            }
            LDS_WAIT(); __syncthreads();
            { unsigned z1_ = 0u; asm volatile("" : "+v"(z1_)); const int tid2 = wave0_ * 64 + (int)__builtin_amdgcn_mbcnt_hi(~0u, __builtin_amdgcn_mbcnt_lo(~0u, z1_));
              if (tid2 < 16) cnt_wg[bx * 16 + tid2] = lcnt[tid2]; }
        }
        SEAM(pb + 7);
        if (IN(pb + 9)) REP(9) { PHASE_PTRS();
            LAS int* tab = (LAS int*)(lds + 0);
            LAS int* part = (LAS int*)(lds + 16384);
            LAS int* tot = (LAS int*)(lds + 16384 + 2048);
            LAS int* eoff = (LAS int*)(lds + 16384 + 2048 + 64);
            LAS int* mybase = (LAS int*)(lds + 16384 + 2048 + 192);
            LAS int* cur = (LAS int*)(lds + 16384 + 2048 + 256);
            for (int i = tid; i < G * 16; i += 512) tab[i] = cnt_wg[i];
            LDS_WAIT(); __syncthreads();
            { const int e = tid & 15, ch = tid >> 4; int sacc = 0; for (int j = 0; j < 8; ++j) { const int wgi = ch * 8 + j; if (wgi < G) sacc += tab[wgi * 16 + e]; } part[ch * 16 + e] = sacc; }
            LDS_WAIT(); __syncthreads();
            if (tid < 16) { int sall = 0, sbefore = 0; const int mych = bx >> 3;
                for (int ch = 0; ch < 32; ++ch) { const int v = part[ch * 16 + tid]; sall += v; if (ch < mych) sbefore += v; }
                for (int wgi = mych * 8; wgi < bx; ++wgi) sbefore += tab[wgi * 16 + tid];
                tot[tid] = sall; mybase[tid] = sbefore; cur[tid] = 0; }
            LDS_WAIT(); __syncthreads();
            if (tid == 0) { int o = 0; for (int e = 0; e < 16; ++e) { eoff[e] = o; o += (tot[e] + 255) & ~255; } eoff[16] = o; }
            LDS_WAIT(); __syncthreads();
            if (bx == 0 && tid <= 16) tile_off_g[tid] = eoff[tid] >> 8;
            for (int tb = bx * 128; tb < T; tb += G * 128) {
                LAS int* wcnt = part;
                int e = -1; const int t = tb + (tid >> 1), k = tid & 1;
                if (tid < 256) e = route_e[t * 2 + k];
                int rank_in_wave = 0;
                if (tid < 256) {
#pragma unroll
                    for (int x = 0; x < 16; ++x) { const unsigned long long m = __ballot(e == x); if (e == x) rank_in_wave = __popcll(m & ((1ull << lane) - 1ull)); if (lane == 0) wcnt[wave * 16 + x] = __popcll(m); }
                }
                LDS_WAIT(); __syncthreads();
                if (tid < 256) { int before = 0; for (int wv = 0; wv < wave; ++wv) before += wcnt[wv * 16 + e];
                    const int p = eoff[e] + mybase[e] + before + rank_in_wave;
                    row_tok[p] = t; row_dst[t * 2 + k] = p; }
                (void)cur;
            }
            if (bx < 16) { const int e = bx; const int beg = eoff[e] + tot[e], end = eoff[e + 1]; for (int p = beg + tid; p < end; p += 512) { row_tok[p] = 0; } }
        }
        SEAM(pb + 9);
        if (IN(pb + 10)) REP(10) { PHASE_PTRS();
            LAS int* toff = (LAS int*)(lds + MISC_OFF + 64);
            if (tid <= 16) toff[tid] = tile_off_g[tid];
            LDS_WAIT(); __syncthreads();
            pg8::SchedMoe S{(const char*)HB8, (const char*)(W8 + W8_GU), D, D, (size_t)2048 * D, 8, G, bx, D / 128, toff, row_tok, true};
            pg8::EpiSwiglu E{HID8, W8_INV};
            pg8::gemm_phase<pg8::EpiSwiglu, pg8::SchedMoe, true, true, true>(lds, S, E, tid);
        }
        SEAM(pb + 10);
        if (IN(pb + 11)) REP(11) { PHASE_PTRS();
            LAS int* toff = (LAS int*)(lds + MISC_OFF + 64);
            if (tid <= 16) toff[tid] = tile_off_g[tid];
            LDS_WAIT(); __syncthreads();
            pg8::SchedMoe S{(const char*)HID8, (const char*)(W8 + W8_DN), DEXP, DEXP, (size_t)D * DEXP, 8, G, bx, DEXP / 128, toff, nullptr, true};
            pg8::EpiDown E{YB, W8_INV * HID8_INV};
            pg8::gemm_phase<pg8::EpiDown, pg8::SchedMoe, true, false, true>(lds, S, E, tid);
        }
        SEAM(pb + 11);
        if (IN(pb + 12)) { PHASE_PTRS();
            const float* g2 = A_->ln2_g + l * D; const float* b2 = A_->ln2_b + l * D;
            LAS f32x4* gbL = (LAS f32x4*)lds;
            for (int i = tid; i < 1024; i += 512) gbL[i] = (i < 512) ? *((const f32x4*)g2 + i) : *((const f32x4*)b2 + (i - 512));
            LDS_WAIT(); __syncthreads();
            f32x4 hA[8], hB[8]; u32x2 yaA[8], ycA[8], yaB[8], ycB[8]; float w0A = 0.f, w1A = 0.f, w0B = 0.f, w1B = 0.f;
            int s0i = 0, s1i = 0; float w0i = 0.f, w1i = 0.f;
            typedef const __attribute__((address_space(4))) int c4i; typedef const __attribute__((address_space(4))) float c4f;
            c4i* rd4 = (c4i*)row_dst; c4f* rw4 = (c4f*)route_w;
            auto load_idx = [&](int t) { s0i = rd4[t * 2]; s1i = rd4[t * 2 + 1]; w0i = rw4[t * 2]; w1i = rw4[t * 2 + 1]; };
#define LN2_FETCH(H_, YA_, YC_, W0_, W1_, t_) do { const f32x4* hp = (const f32x4*)(A_->out + (size_t)(t_) * D) + lane; W0_ = w0i; W1_ = w1i; \
                const u32x2* y0 = (const u32x2*)(YB + (size_t)s0i * D) + lane; const u32x2* y1 = (const u32x2*)(YB + (size_t)s1i * D) + lane; \
                _Pragma("unroll") for (int j = 0; j < 8; ++j) { H_[j] = __builtin_nontemporal_load(hp + 64 * j); YA_[j] = __builtin_nontemporal_load(y0 + 64 * j); YC_[j] = __builtin_nontemporal_load(y1 + 64 * j); } } while (0)
#define LN2_ROW(H_, YA_, YC_, W0_, W1_, t_, WR8_) do { const int tr_ = (t_); \
                f32x4 v[8]; float sm = 0.f; const float w0 = W0_, w1 = W1_; \
                _Pragma("unroll") for (int j = 0; j < 8; ++j) { u32x2 a = YA_[j], c = YC_[j]; asm volatile("" : "+v"(a), "+v"(c));        \
                    const f32x4 ya = (f32x4){bflo(a.x), bfhi(a.x), bflo(a.y), bfhi(a.y)}, yc = (f32x4){bflo(c.x), bfhi(c.x), bflo(c.y), bfhi(c.y)}; \
                    v[j] = H_[j] * DN_ALPHA + (ya * w0 + yc * w1); sm += (v[j][0] + v[j][1]) + (v[j][2] + v[j][3]); } \
                { const int tn = tr_ + 2 * NGW < T ? tr_ + 2 * NGW : tr_; LN2_FETCH(H_, YA_, YC_, W0_, W1_, tn); load_idx(tr_ + 3 * NGW < T ? tr_ + 3 * NGW : tr_); } \
                const float mean = wave_sum(sm) * (1.f / D); float s2 = 0.f; \
                _Pragma("unroll") for (int j = 0; j < 8; ++j) { v[j] = v[j] - mean; s2 += (v[j][0] * v[j][0] + v[j][1] * v[j][1]) + (v[j][2] * v[j][2] + v[j][3] * v[j][3]); } \
                const float rstd = 1.f / sqrtf(wave_sum(s2) * (1.f / D) + LN_EPS); \
                f32x4* op = (f32x4*)(A_->out + (size_t)tr_ * D) + lane; unsigned* o8 = (unsigned*)(HB8 + (size_t)tr_ * D) + lane; \
                unsigned gbo_ = (unsigned)lane * 16u; asm volatile("" : "+v"(gbo_));        \
                _Pragma("unroll") for (int j = 0; j < 8; ++j) { const f32x4 gg = *(const LAS f32x4*)(lds + gbo_ + 1024 * j), bb = *(const LAS f32x4*)(lds + gbo_ + 8192 + 1024 * j); \
                    const f32x4 y = v[j] * rstd * gg + bb; op[64 * j] = y; \
                    if (WR8_) { int t0 = 0; t0 = __builtin_amdgcn_cvt_pk_fp8_f32(y[0], y[1], t0, false); t0 = __builtin_amdgcn_cvt_pk_fp8_f32(y[2], y[3], t0, true); o8[64 * j] = (unsigned)t0; } } } while (0)
#define LN2_ALL(WR8_) do { \
            { const int r0 = gw, r1 = r0 + NGW, r2 = r0 + 2 * NGW < T ? r0 + 2 * NGW : r0; \
              load_idx(r0); LN2_FETCH(hA, yaA, ycA, w0A, w1A, r0); load_idx(r1); LN2_FETCH(hB, yaB, ycB, w0B, w1B, r1); load_idx(r2); } \
            { LN2_ROW(hA, yaA, ycA, w0A, w1A, gw, WR8_); LN2_ROW(hB, yaB, ycB, w0B, w1B, gw + NGW, WR8_); } \
            for (int t = gw + 2 * NGW; t + NGW < T; t += 2 * NGW) { LN2_ROW(hA, yaA, ycA, w0A, w1A, t, WR8_); LN2_ROW(hB, yaB, ycB, w0B, w1B, t + NGW, WR8_); } } while (0)
            if (l + 1 < DEPTH) LN2_ALL(true); else LN2_ALL(false);
#undef LN2_ALL
#undef LN2_FETCH
#undef LN2_ROW
        }
        if (l + 1 == DEPTH) SEAM(pb + 12); else __syncthreads();
    }
#ifdef DBG_DUMP
    if (lo == 999) { const int l = 0; PHASE_PTRS();
        const bf16* src = (const bf16*)(ws + DBG_DUMP_OFF);
        for (size_t i = (size_t)bx * 512 + tid; i < (size_t)T * D; i += (size_t)G * 512) { const size_t t = i / D, c = i % D; const unsigned w = src[t * DBG_DUMP_PITCH + DBG_DUMP_COL + c]; A_->out[i] = bflo(w); }
    }
#endif
#undef IN
#undef SEAM
}

extern "C" void kernel_launch(void* const* d_in, const int* in_sizes, int n_in, void* d_out, int out_size, void* d_ws, size_t ws_size, hipStream_t stream) {
    static int grid = 0;
    if (grid == 0) {
        if (n_in != 19 || in_sizes[0] != T * D || out_size != T * D || ws_size < WS_END) { fprintf(stderr, "kernel_launch: unexpected shapes / workspace (n_in %d, ws %zu); nothing launched\n", n_in, ws_size); grid = -1; return; }
        int dev = 0, cus = 0, per_cu = 0;
        if (hipGetDevice(&dev) != hipSuccess || hipDeviceGetAttribute(&cus, hipDeviceAttributeMultiprocessorCount, dev) != hipSuccess) { grid = -1; return; }
        if (hipFuncSetAttribute((const void*)mega_fwd, hipFuncAttributeMaxDynamicSharedMemorySize, LDS_BYTES) != hipSuccess) { fprintf(stderr, "kernel_launch: hipFuncSetAttribute failed\n"); grid = -1; return; }
        if (hipOccupancyMaxActiveBlocksPerMultiprocessor(&per_cu, (const void*)mega_fwd, 512, LDS_BYTES) != hipSuccess || per_cu < 1) fprintf(stderr, "kernel_launch: occupancy query says %d\n", per_cu);
        (void)hipGetLastError();
        grid = cus;
    }
    if (grid < 0) return;
    (void)hipMemsetAsync((char*)d_ws + WS_CTL, 0, CTL_ZERO_BYTES, stream);
    Args a{};
    a.x = (const float*)d_in[0]; a.pos = (const int*)d_in[1]; a.w_in = (const float*)d_in[2]; a.w_gate = (const float*)d_in[3]; a.b_gate = (const float*)d_in[4];
    a.w_br_a = (const float*)d_in[5]; a.w_br_b = (const float*)d_in[6]; a.w_br_c = (const float*)d_in[7]; a.w_out = (const float*)d_in[8]; a.sinks = (const float*)d_in[9];
    a.ln1_g = (const float*)d_in[10]; a.ln1_b = (const float*)d_in[11]; a.w_rg = (const float*)d_in[12]; a.w_re = (const float*)d_in[13];
    a.w_eg = (const float*)d_in[14]; a.w_eu = (const float*)d_in[15]; a.w_ed = (const float*)d_in[16]; a.ln2_g = (const float*)d_in[17]; a.ln2_b = (const float*)d_in[18];
    a.out = (float*)d_out; a.ws = (unsigned char*)d_ws; a.pad = 0;
#if MK_ONE_LAUNCH
    a.ph_lo = 0; a.ph_hi = DEPTH * NPH; a.li = 0;
    hipLaunchKernelGGL(mega_fwd, dim3(grid), dim3(512), LDS_BYTES, stream, a);
#else
#ifndef DBG_NPHASES
#define DBG_NPHASES (DEPTH * NPH)
#endif
    for (int p = 0; p < DBG_NPHASES; ++p) { a.ph_lo = p; a.ph_hi = p + 1; a.li = 0; hipLaunchKernelGGL(mega_fwd, dim3(grid), dim3(512), LDS_BYTES, stream, a); }
#ifdef DBG_DUMP
    a.ph_lo = 999; a.ph_hi = 1000; hipLaunchKernelGGL(mega_fwd, dim3(grid), dim3(512), LDS_BYTES, stream, a);
#endif
#endif
}
```
